# Optimizing an MI355X kernel written in HIP

```python
import jax, jax.numpy as jnp
from jax import lax
import numpy as np

D_MODEL = 1024
BATCH = 8
SEQ = 8192
DEPTH = 1
DEC_BATCH = 128
DEC_SEQ = 8
PAST_LEN = 8192
PAGE_SIZE = 128

HEAD_DIM = 64
HEADS_PER_GROUP = 4
GROUPS = ((128, 1), (512, 4), (2048, 16))
N_GROUPS = 3
N_ATT_HEADS = N_GROUPS * HEADS_PER_GROUP
ATT_W = N_ATT_HEADS * HEAD_DIM
ATT_OUT_W = HEADS_PER_GROUP * HEAD_DIM
CONV_W = D_MODEL // 2
CONV_K = 3
D_FF = 4 * D_MODEL
N_BUCKETS = 32
MAX_DISTANCE = 2048
BLOCK = 128
EPS = 1e-6
SCALE = HEAD_DIM ** -0.5
SPLITS = (ATT_W, ATT_W, ATT_W, CONV_W, CONV_W, CONV_W, D_MODEL, D_MODEL)
PROJ_W = 3 * ATT_W + 3 * CONV_W + 2 * D_MODEL

kernel_name = "hybrid_dilated_attn_gated_conv_step"


def rmsnorm(x, g):
    xf = x.astype(jnp.float32)
    y = xf * lax.rsqrt(jnp.mean(xf * xf, axis=-1, keepdims=True) + EPS)
    return (y * g.astype(jnp.float32)).astype(x.dtype)


def t5_bucket(dist):
    n = np.asarray(dist)
    max_exact = N_BUCKETS // 2
    large = max_exact + (np.log(np.maximum(n, 1) / max_exact) / np.log(MAX_DISTANCE / max_exact)
                         * (N_BUCKETS - max_exact)).astype(np.int32)
    large = np.minimum(large, N_BUCKETS - 1)
    return np.where(n < max_exact, n, large).astype(np.int32)


def group_bias(rel_bias, g):
    win, dil = GROUPS[g]
    kb = win // dil
    buckets = t5_bucket(np.arange(kb + 1) * dil)
    sl = slice(g * HEADS_PER_GROUP, (g + 1) * HEADS_PER_GROUP)
    return rel_bias[buckets][:, sl].astype(jnp.float32)


def dilated_attn_prompt(q, k, v, bias, dil, kb):
    B, S, H, E = q.shape
    L = S // dil
    nb = -(-L // BLOCK)
    Lp = nb * BLOCK

    def to_res(t):
        t = t.reshape(B, L, dil, H, E).transpose(0, 2, 1, 3, 4).astype(jnp.float32)
        return jnp.pad(t, ((0, 0), (0, 0), (0, Lp - L), (0, 0), (0, 0)))

    def windows(t):
        t = jnp.pad(to_res(t), ((0, 0), (0, 0), (BLOCK, 0), (0, 0), (0, 0)))
        t = t.reshape(B, dil, nb + 1, BLOCK, H, E)
        return jnp.concatenate([t[:, :, :-1], t[:, :, 1:]], axis=3)

    qb = to_res(q).reshape(B, dil, nb, BLOCK, H, E)
    kw, vw = windows(k), windows(v)
    a = np.arange(BLOCK)[:, None]
    c = np.arange(2 * BLOCK)[None, :]
    rel = BLOCK + a - c
    kidx = (np.arange(nb)[:, None, None] - 1) * BLOCK + c[None]
    valid = (rel >= 0) & (rel <= kb) & (kidx >= 0)
    bias_rel = bias[np.clip(rel, 0, kb)].transpose(2, 0, 1)
    s = jnp.einsum('bdnqhe,bdnkhe->bdnhqk', qb, kw) * SCALE + bias_rel[None, None, None]
    s = jnp.where(valid[None, None, :, None], s, -jnp.inf)
    lse = jax.nn.logsumexp(s, axis=-1)
    p = jnp.exp(s - lse[..., None])
    o = jnp.einsum('bdnhqk,bdnkhe->bdnqhe', p, vw)
    o = o.reshape(B, dil, Lp, H, E)[:, :, :L].transpose(0, 2, 1, 3, 4).reshape(B, S, H, E)
    lse = lse.transpose(0, 1, 2, 4, 3).reshape(B, dil, Lp, H)[:, :, :L]
    lse = lse.transpose(0, 2, 1, 3).reshape(B, S, H)
    return o, lse


def dilated_attn_sample(q, k, v, kv_buf, bias, dil, kb):
    Bd, T, H, E = q.shape
    Wb = kv_buf.shape[1]
    k_all = jnp.concatenate([kv_buf[:, :, 0].astype(k.dtype), k], axis=1).astype(jnp.float32)
    v_all = jnp.concatenate([kv_buf[:, :, 1].astype(v.dtype), v], axis=1).astype(jnp.float32)
    idx = Wb + np.arange(T)[:, None] - np.arange(kb + 1)[None, :] * dil
    valid = idx >= 0
    idx = np.maximum(idx, 0)
    kg = k_all[:, idx]
    vg = v_all[:, idx]
    s = jnp.einsum('bthe,btjhe->bhtj', q.astype(jnp.float32), kg) * SCALE + bias.T[None, :, None, :]
    s = jnp.where(valid[None, None], s, -jnp.inf)
    lse = jax.nn.logsumexp(s, axis=-1)
    p = jnp.exp(s - lse[..., None])
    o = jnp.einsum('bhtj,btjhe->bthe', p, vg)
    return o, lse.transpose(0, 2, 1)


def dilated_attention(q, k, v, rel_bias, kv_bufs):
    S = q.shape[1]
    outs, lses, rows = [], [], []
    for g, (win, dil) in enumerate(GROUPS):
        sl = slice(g * HEADS_PER_GROUP, (g + 1) * HEADS_PER_GROUP)
        kb = win // dil
        qg, kg, vg = q[:, :, sl], k[:, :, sl], v[:, :, sl]
        bias = group_bias(rel_bias, g)
        kv = jnp.stack([kg, vg], axis=2)
        if kv_bufs is None:
            o, l = dilated_attn_prompt(qg, kg, vg, bias, dil, kb)
            rows.append(kv[:, -min(win, S):])
        else:
            o, l = dilated_attn_sample(qg, kg, vg, kv_bufs[g], bias, dil, kb)
            rows.append(kv)
        outs.append(o)
        lses.append(l)
    w = jax.nn.softmax(jnp.stack(lses, 0), axis=0)
    o = jnp.einsum('gbsh,gbshe->bshe', w, jnp.stack(outs, 0))
    B = q.shape[0]
    return o.reshape(B, S, ATT_OUT_W), rows


def layer(x, conv_prefix, kv_bufs, rel_bias, w_in, w_att_out, w_conv_out, w_o, conv_w, conv_b,
          norm_mix, norm_mlp, w_ff1, w_ff2):
    B, S, _ = x.shape
    xn = rmsnorm(x, norm_mix)
    proj = xn @ w_in
    q, k, v, cb, cc, ch, ga, gb = jnp.split(proj, [int(i) for i in np.cumsum(SPLITS)[:-1]], axis=-1)
    q = q.reshape(B, S, N_ATT_HEADS, HEAD_DIM)
    k = k.reshape(B, S, N_ATT_HEADS, HEAD_DIM)
    v = v.reshape(B, S, N_ATT_HEADS, HEAD_DIM)
    att, kv_rows = dilated_attention(q, k, v, rel_bias, kv_bufs)
    u = cc * ch
    u_pad = jnp.concatenate([conv_prefix.astype(u.dtype), u], axis=1)
    z = conv_b + conv_w[0] * u_pad[:, 0:S] + conv_w[1] * u_pad[:, 1:S + 1] + conv_w[2] * u_pad[:, 2:S + 2]
    conv_state = u_pad[:, -(CONV_K - 1):]
    branch_a = att.astype(x.dtype) @ w_att_out
    branch_b = (cb * z) @ w_conv_out
    m = jax.nn.sigmoid(ga) * branch_a + jax.nn.sigmoid(gb) * branch_b
    x = x + m @ w_o
    h = rmsnorm(x, norm_mlp)
    x = x + jnp.square(jax.nn.relu(h @ w_ff1)) @ w_ff2
    return x, kv_rows, conv_state


def setup_inputs(seed: int = 0) -> dict:
    key = jax.random.key(seed)
    ks = jax.random.split(key, 20)
    f32 = jnp.float32
    n = lambda k, shape, s: jax.random.normal(k, shape, f32) * s
    wb = [min(win, PAST_LEN) for win, _ in GROUPS]
    return {
        "x_prompt": n(ks[0], (BATCH, SEQ, D_MODEL), 1.0),
        "x_sample": n(ks[1], (DEC_BATCH, DEC_SEQ, D_MODEL), 1.0),
        "cache_kv_g0": n(ks[2], (DEPTH, DEC_BATCH, wb[0], 2, HEADS_PER_GROUP, HEAD_DIM), 1.0),
        "cache_kv_g1": n(ks[3], (DEPTH, DEC_BATCH, wb[1], 2, HEADS_PER_GROUP, HEAD_DIM), 1.0),
        "cache_kv_g2": n(ks[4], (DEPTH, DEC_BATCH, wb[2], 2, HEADS_PER_GROUP, HEAD_DIM), 1.0),
        "state_conv": n(ks[5], (DEPTH, DEC_BATCH, CONV_K - 1, CONV_W), 1.0),
        "w_in": n(ks[6], (DEPTH, D_MODEL, PROJ_W), D_MODEL ** -0.5),
        "w_att_out": n(ks[7], (DEPTH, ATT_OUT_W, D_MODEL), ATT_OUT_W ** -0.5),
        "w_conv_out": n(ks[8], (DEPTH, CONV_W, D_MODEL), CONV_W ** -0.5),
        "w_o": n(ks[9], (DEPTH, D_MODEL, D_MODEL), D_MODEL ** -0.5),
        "conv_w": n(ks[10], (DEPTH, CONV_K, CONV_W), CONV_K ** -0.5),
        "conv_b": n(ks[11], (DEPTH, CONV_W), 0.02),
        "rel_bias": n(ks[12], (N_BUCKETS, N_ATT_HEADS), 0.5),
        "norm_mix": 1.0 + n(ks[13], (DEPTH, D_MODEL), 0.05),
        "norm_mlp": 1.0 + n(ks[14], (DEPTH, D_MODEL), 0.05),
        "w_ff1": n(ks[15], (DEPTH, D_MODEL, D_FF), D_MODEL ** -0.5),
        "w_ff2": n(ks[16], (DEPTH, D_FF, D_MODEL), D_FF ** -0.5),
        "norm_final": 1.0 + n(ks[17], (D_MODEL,), 0.05),
    }


def reference(x_prompt, x_sample, cache_kv_g0, cache_kv_g1, cache_kv_g2, state_conv, w_in, w_att_out,
              w_conv_out, w_o, conv_w, conv_b, rel_bias, norm_mix, norm_mlp, w_ff1, w_ff2, norm_final):
    caches = (cache_kv_g0, cache_kv_g1, cache_kv_g2)
    xp, xs = x_prompt, x_sample
    kvp = [[] for _ in range(N_GROUPS)]
    kvs = [[] for _ in range(N_GROUPS)]
    convp, convs = [], []
    for l in range(DEPTH):
        wts = (w_in[l], w_att_out[l], w_conv_out[l], w_o[l], conv_w[l], conv_b[l],
               norm_mix[l], norm_mlp[l], w_ff1[l], w_ff2[l])
        prompt_prefix = jnp.zeros((xp.shape[0], CONV_K - 1, CONV_W), xp.dtype)
        xp, rows_p, cp = layer(xp, prompt_prefix, None, rel_bias, *wts)
        xs, rows_s, cs = layer(xs, state_conv[l], [c[l] for c in caches], rel_bias, *wts)
        for g in range(N_GROUPS):
            kvp[g].append(rows_p[g])
            kvs[g].append(rows_s[g])
        convp.append(cp)
        convs.append(cs)
    y_prompt = rmsnorm(xp, norm_final)
    y_sample = rmsnorm(xs, norm_final)
    return (y_prompt, y_sample,
            jnp.stack(kvp[0], 0), jnp.stack(kvp[1], 0), jnp.stack(kvp[2], 0), jnp.stack(convp, 0),
            jnp.stack(kvs[0], 0), jnp.stack(kvs[1], 0), jnp.stack(kvs[2], 0), jnp.stack(convs, 0))
```

```cpp
#include <hip/hip_runtime.h>
#include <cstdio>
#include <cstdint>
namespace pg8 {
#define PG8_LAS __attribute__((address_space(3)))
typedef unsigned short bf16_t;
typedef short bf16x8 __attribute__((ext_vector_type(8)));
typedef float f32x4 __attribute__((ext_vector_type(4)));
typedef unsigned u32x4 __attribute__((ext_vector_type(4)));
constexpr int BM = 256, BK = 64, HALF = 128, HTB = HALF * BK * 2  , STAGE_BYTES = 8 * HTB, NXCD = 8, WGM = 8;

__host__ __device__ __forceinline__ int lds_byte(int r, int c) { const int st = (r >> 4) * 2 + (c >> 5), rr = r & 15, cc = c & 31, ob = rr * 64 + cc * 2; return st * 1024 + (ob ^ (((ob >> 9) & 1) << 5)); }
__host__ __device__ __forceinline__ void stage_rc(int b, int& R, int& C) { const int st = b / 1024, sb = b % 1024, swz = sb ^ (((sb >> 9) & 1) << 5); R = (st >> 1) * 16 + swz / 64; C = (st & 1) * 32 + (swz % 64) / 2; }
__host__ __device__ __forceinline__ int perm32(int rho) { const int n = rho >> 4, i = rho & 15; return 8 * (i >> 2) + 4 * n + (i & 3); }

struct Unit { int pm, pn; };
struct Gemm { const bf16_t* A; const bf16_t* Bt; int M, N, K; };

struct StaticOrder {
    int nM, nN, nwg, G, c;
    __host__ __device__ void init(int M, int N, int G_, int c_) { nM = M / BM; nN = N / BM; nwg = nM * nN; G = G_; c = c_; }
    __host__ __device__ bool next(int i, Unit& u) const {
        const long L = (long)i * G + c; if (L >= nwg) return false;
        int wgid = (int)L; { const int q = nwg / NXCD, r = nwg % NXCD, xcd = wgid % NXCD, off = wgid / NXCD; wgid = (xcd < r ? xcd * (q + 1) : r * (q + 1) + (xcd - r) * q) + off; }
        const int nig = WGM * nN, gid = wgid / nig, fm = gid * WGM, gsz = (nM - fm) < WGM ? (nM - fm) : WGM;
        u.pm = fm + ((wgid % nig) % gsz); u.pn = (wgid % nig) / gsz; return true;
    }
    __device__ __forceinline__ void a_ready(const Unit&) const {}
    __device__ __forceinline__ void done(const Unit&) const {}
};

__device__ __forceinline__ unsigned cvt_pk_bf16(float lo, float hi) { unsigned r; asm volatile("v_cvt_pk_bf16_f32 %0, %1, %2" : "=v"(r) : "v"(lo), "v"(hi)); return r; }
typedef float f32x2 __attribute__((ext_vector_type(2)));
typedef unsigned u32x2 __attribute__((ext_vector_type(2)));
constexpr int P_MP = 65536, P_MT = 66560, P_PW = 5888, P_D = 1024, P_FF = 4096;
constexpr float P_EPS = 1e-6f;
constexpr float P_QSCALE = 0.125f * 1.4426950408889634f;
constexpr size_t O_Y = 0, O_KVP0 = 68157440, O_KVP1 = 68681728, O_KVP2 = 70778880, O_CONVP = 79167488, O_KVS0 = 79175680, O_KVS1 = 79699968, O_KVS2 = 80224256, O_CONVS = 80748544, O_END = 80879616;
__device__ __forceinline__ float bf_lo(unsigned w) { return __uint_as_float(w << 16); }
__device__ __forceinline__ float bf_hi(unsigned w) { return __uint_as_float(w & 0xffff0000u); }

struct EpiProj {
    static constexpr bool PERM = true, AFTER_DRAIN = false, HAS_MID = false; static constexpr int MID_T = 0;
    bf16_t* P; const float* rstd; float* out;
    __device__ __forceinline__ void operator()(const f32x4 (&acc)[2][2][4][2], const Unit& u, int wr, int wc, int fr, int fq) const {
        const int pn = u.pn;
        const float qs = (pn < 3) ? P_QSCALE : 1.f;
        const bool iskv = (pn >= 3 && pn < 9);
        const int g = iskv ? (pn - 3) % 3 : 0, kv = iskv ? (pn - 3) / 3 : 0;
        const int win = 128 << (2 * g);
        const size_t okp = g == 0 ? O_KVP0 : (g == 1 ? O_KVP1 : O_KVP2), oks = g == 0 ? O_KVS0 : (g == 1 ? O_KVS1 : O_KVS2);
        const int cin = wc * 32 + 8 * fq;
#pragma unroll
        for (int ai = 0; ai < 2; ++ai)
#pragma unroll
            for (int m = 0; m < 4; ++m) {
                const int row = u.pm * BM + ai * HALF + wr * 64 + m * 16 + fr;
                const float rs = rstd[row] * qs;
                bf16_t* rowp = P + (size_t)row * P_PW + pn * BM + cin;
                float* kvp = nullptr;
                if (iskv) {
                    if (row >= P_MP) kvp = out + oks + ((size_t)(row - P_MP) * 2 + kv) * 256 + cin;
                    else { const int b = row >> 13, t = row & 8191; if (t >= 8192 - win) kvp = out + okp + ((size_t)(b * win + t - (8192 - win)) * 2 + kv) * 256 + cin; }
                }
#pragma unroll
                for (int bj = 0; bj < 2; ++bj) {
                    const f32x4 v0 = acc[ai][bj][m][0] * rs, v1 = acc[ai][bj][m][1] * rs;
                    u32x4 w; w.x = cvt_pk_bf16(v0[0], v0[1]); w.y = cvt_pk_bf16(v0[2], v0[3]); w.z = cvt_pk_bf16(v1[0], v1[1]); w.w = cvt_pk_bf16(v1[2], v1[3]);
                    *(u32x4*)(rowp + bj * HALF) = w;
                    if (kvp) { *(f32x4*)(kvp + bj * HALF) = v0; *(f32x4*)(kvp + bj * HALF + 4) = v1; }
                }
            }
    }
};

struct EpiGate {
    static constexpr bool PERM = true, AFTER_DRAIN = false, HAS_MID = true; static constexpr int MID_T = 4;
    bf16_t* Mo; const bf16_t* P;
    __device__ __forceinline__ void mid(f32x4 (&acc)[2][2][4][2], const Unit& u, int wr, int wc, int fr, int fq) const {
        const int c0 = u.pn * BM + wc * 32 + 8 * fq;
        int row0 = u.pm * BM + wr * 64 + fr;
        asm volatile("" : "+v"(row0));
#pragma unroll
        for (int ai = 0; ai < 2; ++ai)
#pragma unroll
            for (int m = 0; m < 4; ++m) {
                const int row = row0 + ai * HALF + m * 16;
                const bf16_t* gp = P + (size_t)row * P_PW + c0;
#pragma unroll
                for (int bj = 0; bj < 2; ++bj) {
                    const u32x4 a = *(const u32x4*)(gp + 3840 + bj * HALF), b = *(const u32x4*)(gp + 4864 + bj * HALF);
                    float r[8];
#pragma unroll
                    for (int i = 0; i < 4; ++i) {
                        const float a0 = bf_lo(a[i]), a1 = bf_hi(a[i]), b0 = bf_lo(b[i]), b1 = bf_hi(b[i]);
                        r[2 * i]     = (1.f + __builtin_amdgcn_exp2f(-1.4426950408889634f * b0)) * __builtin_amdgcn_rcpf(1.f + __builtin_amdgcn_exp2f(-1.4426950408889634f * a0));
                        r[2 * i + 1] = (1.f + __builtin_amdgcn_exp2f(-1.4426950408889634f * b1)) * __builtin_amdgcn_rcpf(1.f + __builtin_amdgcn_exp2f(-1.4426950408889634f * a1));
                    }
                    acc[ai][bj][m][0] = acc[ai][bj][m][0] * (f32x4){r[0], r[1], r[2], r[3]};
                    acc[ai][bj][m][1] = acc[ai][bj][m][1] * (f32x4){r[4], r[5], r[6], r[7]};
                }
                if (m & 1) asm volatile("" ::: "memory");
            }
    }
    __device__ __forceinline__ void operator()(const f32x4 (&acc)[2][2][4][2], const Unit& u, int wr, int wc, int fr, int fq) const {
        const int c0 = u.pn * BM + wc * 32 + 8 * fq;
#pragma unroll
        for (int ai = 0; ai < 2; ++ai)
#pragma unroll
            for (int m = 0; m < 4; ++m) {
                const int row = u.pm * BM + ai * HALF + wr * 64 + m * 16 + fr;
                const bf16_t* gp = P + (size_t)row * P_PW + 4864 + c0;
                bf16_t* op = Mo + (size_t)row * P_D + c0;
#pragma unroll
                for (int bj = 0; bj < 2; ++bj) {
                    const u32x4 b = *(const u32x4*)(gp + bj * HALF);
                    float s[8];
#pragma unroll
                    for (int i = 0; i < 4; ++i) {
                        s[2 * i]     = __builtin_amdgcn_rcpf(1.f + __builtin_amdgcn_exp2f(-1.4426950408889634f * bf_lo(b[i])));
                        s[2 * i + 1] = __builtin_amdgcn_rcpf(1.f + __builtin_amdgcn_exp2f(-1.4426950408889634f * bf_hi(b[i])));
                    }
                    const f32x4 v0 = acc[ai][bj][m][0] * (f32x4){s[0], s[1], s[2], s[3]}, v1 = acc[ai][bj][m][1] * (f32x4){s[4], s[5], s[6], s[7]};
                    u32x4 w; w.x = cvt_pk_bf16(v0[0], v0[1]); w.y = cvt_pk_bf16(v0[2], v0[3]); w.z = cvt_pk_bf16(v1[0], v1[1]); w.w = cvt_pk_bf16(v1[2], v1[3]);
                    *(u32x4*)(op + bj * HALF) = w;
                }
            }
    }
};

struct EpiRes1 {
    static constexpr bool PERM = true, AFTER_DRAIN = false, HAS_MID = false; static constexpr int MID_T = 0;
    const float* xp; const float* xs; float* X1; bf16_t* X1B; float* ssq;
    __device__ __forceinline__ void operator()(const f32x4 (&acc)[2][2][4][2], const Unit& u, int wr, int wc, int fr, int fq) const {
        const int c0 = u.pn * BM + wc * 32 + 8 * fq;
        const float* xb = (u.pm * BM >= P_MP) ? xs - (size_t)P_MP * P_D : xp;
#pragma unroll
        for (int ai = 0; ai < 2; ++ai)
#pragma unroll
            for (int m = 0; m < 4; ++m) {
                const int row = u.pm * BM + ai * HALF + wr * 64 + m * 16 + fr;
                const size_t off = (size_t)row * P_D + c0;
                float sq = 0.f;
#pragma unroll
                for (int bj = 0; bj < 2; ++bj) {
                    const f32x4 x0 = *(const f32x4*)(xb + off + bj * HALF), x1 = *(const f32x4*)(xb + off + bj * HALF + 4);
                    const f32x4 v0 = acc[ai][bj][m][0] + x0, v1 = acc[ai][bj][m][1] + x1;
                    *(f32x4*)(X1 + off + bj * HALF) = v0; *(f32x4*)(X1 + off + bj * HALF + 4) = v1;
                    u32x4 w; w.x = cvt_pk_bf16(v0[0], v0[1]); w.y = cvt_pk_bf16(v0[2], v0[3]); w.z = cvt_pk_bf16(v1[0], v1[1]); w.w = cvt_pk_bf16(v1[2], v1[3]);
                    *(u32x4*)(X1B + off + bj * HALF) = w;
                    sq += (v0[0] * v0[0] + v0[1] * v0[1]) + (v0[2] * v0[2] + v0[3] * v0[3]) + (v1[0] * v1[0] + v1[1] * v1[1]) + (v1[2] * v1[2] + v1[3] * v1[3]);
                }
                sq += __shfl_xor(sq, 16); sq += __shfl_xor(sq, 32);
                if (fq == 0) ssq[(size_t)row * 16 + u.pn * 4 + wc] = sq;
            }
    }
};

struct EpiFF1 {
    static constexpr bool PERM = true, AFTER_DRAIN = false, HAS_MID = false; static constexpr int MID_T = 0;
    bf16_t* Hd; const float* ssq;
    __device__ __forceinline__ void operator()(const f32x4 (&acc)[2][2][4][2], const Unit& u, int wr, int wc, int fr, int fq) const {
        const int c0 = u.pn * BM + wc * 32 + 8 * fq;
#pragma unroll
        for (int ai = 0; ai < 2; ++ai)
#pragma unroll
            for (int m = 0; m < 4; ++m) {
                const int row = u.pm * BM + ai * HALF + wr * 64 + m * 16 + fr;
                const f32x4* sp = (const f32x4*)(ssq + (size_t)row * 16);
                const f32x4 s0 = sp[0], s1 = sp[1], s2 = sp[2], s3 = sp[3];
                const float tot = ((s0[0] + s0[1]) + (s0[2] + s0[3])) + ((s1[0] + s1[1]) + (s1[2] + s1[3])) + ((s2[0] + s2[1]) + (s2[2] + s2[3])) + ((s3[0] + s3[1]) + (s3[2] + s3[3]));
                const float rs = __builtin_amdgcn_rsqf(tot * (1.f / P_D) + P_EPS);
                bf16_t* op = Hd + (size_t)row * P_FF + c0;
#pragma unroll
                for (int bj = 0; bj < 2; ++bj) {
                    f32x4 v0 = acc[ai][bj][m][0] * rs, v1 = acc[ai][bj][m][1] * rs;
#pragma unroll
                    for (int i = 0; i < 4; ++i) { const float a = fmaxf(v0[i], 0.f), b = fmaxf(v1[i], 0.f); v0[i] = a * a; v1[i] = b * b; }
                    u32x4 w; w.x = cvt_pk_bf16(v0[0], v0[1]); w.y = cvt_pk_bf16(v0[2], v0[3]); w.z = cvt_pk_bf16(v1[0], v1[1]); w.w = cvt_pk_bf16(v1[2], v1[3]);
                    *(u32x4*)(op + bj * HALF) = w;
                }
            }
    }
};

struct EpiRes2 {
    static constexpr bool PERM = true, AFTER_DRAIN = false, HAS_MID = false; static constexpr int MID_T = 0;
    const float* X1; float* Y;
    __device__ __forceinline__ void operator()(const f32x4 (&acc)[2][2][4][2], const Unit& u, int wr, int wc, int fr, int fq) const {
        const int c0 = u.pn * BM + wc * 32 + 8 * fq;
#pragma unroll
        for (int ai = 0; ai < 2; ++ai)
#pragma unroll
            for (int m = 0; m < 4; ++m) {
                const int row = u.pm * BM + ai * HALF + wr * 64 + m * 16 + fr;
                const size_t off = (size_t)row * P_D + c0;
#pragma unroll
                for (int bj = 0; bj < 2; ++bj) {
                    const f32x4 x0 = *(const f32x4*)(X1 + off + bj * HALF), x1 = *(const f32x4*)(X1 + off + bj * HALF + 4);
                    *(f32x4*)(Y + off + bj * HALF) = acc[ai][bj][m][0] + x0; *(f32x4*)(Y + off + bj * HALF + 4) = acc[ai][bj][m][1] + x1;
                }
            }
    }
};

template <class Epi, class Sched, bool ALIGN_EPI = false, bool SP2 = false>
__device__ __forceinline__ void gemm_phase(PG8_LAS unsigned char* lds, const Gemm g, const Sched& S, const Epi& E) {
    const int tid = threadIdx.x, wid = __builtin_amdgcn_readfirstlane(tid >> 6), lane = tid & 63, wr = wid >> 2, wc = wid & 3, fr = lane & 15, fq = lane >> 4;
    const int K = g.K, nt = K / BK;
    unsigned voffA[2], voffB[2];
#pragma unroll
    for (int i = 0; i < 2; ++i) { int R, C; stage_rc(tid * 16 + i * 8192, R, C); const int Rb = Epi::PERM ? ((R & ~31) + perm32(R & 31)) : R;
        voffA[i] = (unsigned)(R * K + C) * 2u; voffB[i] = (unsigned)(Rb * K + C) * 2u; }
    const size_t kstep = (size_t)(BK * 2);
    const size_t hstep = (size_t)HALF * K * 2;
    const size_t tstep = 2 * hstep;
    const unsigned ldsw = (unsigned)wid * 1024u;
    const int aoff = lds_byte(wr * 64 + fr, fq * 8), boff = lds_byte(wc * 32 + fr, fq * 8);
#define PG8_SA(b, h) (((b) * 2 + (h)) * HTB)
#define PG8_SB(b, h) ((4 + (b) * 2 + (h)) * HTB)
#define PG8_STAGE(bufoff, gbase, voff) do { _Pragma("unroll") for (int _i = 0; _i < 2; ++_i) \
        __builtin_amdgcn_global_load_lds((const unsigned*)((const char*)(gbase) + (voff)[_i]), (PG8_LAS unsigned*)(lds + (bufoff) + ldsw + _i * 8192), 16, 0, 0); } while (0)
#define PG8_LDA(dst, b, h) do { _Pragma("unroll") for (int m = 0; m < 4; ++m) _Pragma("unroll") for (int k = 0; k < 2; ++k) dst[m][k] = *(const PG8_LAS bf16x8*)(lds + PG8_SA(b, h) + aoff + m * 2048 + k * 1024); } while (0)
#define PG8_LDB(dst, b, h) do { _Pragma("unroll") for (int n = 0; n < 2; ++n) _Pragma("unroll") for (int k = 0; k < 2; ++k) dst[n][k] = *(const PG8_LAS bf16x8*)(lds + PG8_SB(b, h) + boff + n * 2048 + k * 1024); } while (0)
#define PG8_MMA(ai, bj, At, Bt) do { __builtin_amdgcn_s_setprio(1); _Pragma("unroll") for (int m = 0; m < 4; ++m) _Pragma("unroll") for (int n = 0; n < 2; ++n) _Pragma("unroll") for (int k = 0; k < 2; ++k) \
        acc[ai][bj][m][n] = __builtin_amdgcn_mfma_f32_16x16x32_bf16(Bt[n][k], At[m][k], acc[ai][bj][m][n], 0, 0, 0); __builtin_amdgcn_s_setprio(0); } while (0)
#define PG8_WAIT_V(n) asm volatile("s_waitcnt vmcnt(" #n ")" ::: "memory")
#define PG8_WAIT_L(n) asm volatile("s_waitcnt lgkmcnt(" #n ")" ::: "memory")
#define PG8_BAR __builtin_amdgcn_s_barrier()
#define PG8_SCHED __builtin_amdgcn_sched_barrier(0)
    Unit cur, nxt; int ui = 0;
    if (!S.next(0, cur)) return;
    f32x4 acc[2][2][4][2];
#pragma unroll
    for (int a = 0; a < 2; ++a)
#pragma unroll
        for (int b = 0; b < 2; ++b)
#pragma unroll
            for (int m = 0; m < 4; ++m)
#pragma unroll
                for (int n = 0; n < 2; ++n) acc[a][b][m][n] = (f32x4){0.f, 0.f, 0.f, 0.f};
    bf16x8 At[4][2], B0[2][2], B1[2][2];
    const char* cA = (const char*)g.A + (size_t)cur.pm * tstep; const char* cB = (const char*)g.Bt + (size_t)cur.pn * tstep;
    S.a_ready(cur);
    if constexpr (SP2) {
        PG8_STAGE(PG8_SB(0, 0), cB, voffB); PG8_STAGE(PG8_SB(0, 1), cB + hstep, voffB); PG8_STAGE(PG8_SA(0, 0), cA, voffA); PG8_STAGE(PG8_SA(0, 1), cA + hstep, voffA);
        if (wr == 1) PG8_BAR;
        PG8_WAIT_V(2); PG8_BAR;
        PG8_STAGE(PG8_SB(1, 0), cB + kstep, voffB); PG8_STAGE(PG8_SA(1, 0), cA + kstep, voffA); PG8_STAGE(PG8_SB(1, 1), cB + hstep + kstep, voffB);
        PG8_WAIT_V(6); PG8_BAR;
    } else {
        PG8_STAGE(PG8_SB(0, 0), cB, voffB); PG8_STAGE(PG8_SA(0, 0), cA, voffA); PG8_STAGE(PG8_SB(0, 1), cB + hstep, voffB); PG8_STAGE(PG8_SA(0, 1), cA + hstep, voffA);
        if (wr == 1) PG8_BAR;
        PG8_WAIT_V(4); PG8_BAR;
        PG8_STAGE(PG8_SB(1, 0), cB + kstep, voffB); PG8_STAGE(PG8_SA(1, 0), cA + kstep, voffA); PG8_STAGE(PG8_SB(1, 1), cB + hstep + kstep, voffB);
        PG8_WAIT_V(6); PG8_BAR;
    }
    for (;;) {
        const bool has_next = S.next(ui + 1, nxt);
        const char* nA = has_next ? (const char*)g.A + (size_t)nxt.pm * tstep : cA; const char* nB = has_next ? (const char*)g.Bt + (size_t)nxt.pn * tstep : cB;
        for (int t = 0; t < nt; t += 2) {
            if constexpr (Epi::HAS_MID) { if (t == Epi::MID_T) E.mid(acc, cur, wr, wc, fr, fq); }
            const bool last = (t == nt - 2);
            const char* a1 = cA + (size_t)(t + 1) * kstep;
            const char* a2 = last ? nA : cA + (size_t)(t + 2) * kstep; const char* b2 = last ? nB : cB + (size_t)(t + 2) * kstep;
            const char* a3 = a2 + kstep; const char* b3 = b2 + kstep;
            if (last && has_next) S.a_ready(nxt);
            if constexpr (SP2) {
            PG8_LDB(B0, 0, 0); PG8_LDB(B1, 0, 1); PG8_SCHED; PG8_LDA(At, 0, 0); PG8_STAGE(PG8_SA(1, 1), a1 + hstep, voffA);
            PG8_WAIT_V(8); PG8_WAIT_L(0); PG8_BAR; PG8_MMA(0, 0, At, B0); PG8_MMA(0, 1, At, B1); PG8_BAR; PG8_SCHED;
            PG8_LDA(At, 0, 1); PG8_STAGE(PG8_SB(0, 0), b2, voffB); PG8_STAGE(PG8_SB(0, 1), b2 + hstep, voffB); PG8_STAGE(PG8_SA(0, 0), a2, voffA);
            PG8_WAIT_V(8); PG8_WAIT_L(0); PG8_BAR; PG8_MMA(1, 0, At, B0); PG8_MMA(1, 1, At, B1); PG8_BAR; PG8_SCHED;
            PG8_LDB(B0, 1, 0); PG8_LDB(B1, 1, 1); PG8_SCHED; PG8_LDA(At, 1, 0); PG8_STAGE(PG8_SA(0, 1), a2 + hstep, voffA);
            PG8_WAIT_V(8); PG8_WAIT_L(0); PG8_BAR; PG8_MMA(0, 0, At, B0); PG8_MMA(0, 1, At, B1); PG8_BAR; PG8_SCHED;
            PG8_LDA(At, 1, 1); PG8_STAGE(PG8_SB(1, 0), b3, voffB); PG8_STAGE(PG8_SB(1, 1), b3 + hstep, voffB); PG8_STAGE(PG8_SA(1, 0), a3, voffA);
            PG8_WAIT_V(8); PG8_WAIT_L(0); PG8_BAR; PG8_MMA(1, 0, At, B0); PG8_MMA(1, 1, At, B1); PG8_BAR; PG8_SCHED;
            } else {
            PG8_LDB(B0, 0, 0); PG8_SCHED; PG8_LDA(At, 0, 0); PG8_STAGE(PG8_SA(1, 1), a1 + hstep, voffA);
            PG8_WAIT_L(8); PG8_BAR; PG8_WAIT_L(0); PG8_MMA(0, 0, At, B0); PG8_BAR; PG8_SCHED;
            PG8_LDB(B1, 0, 1); PG8_STAGE(PG8_SB(0, 0), b2, voffB);
            PG8_BAR; PG8_WAIT_L(0); PG8_MMA(0, 1, At, B1); PG8_BAR;
            PG8_LDA(At, 0, 1); PG8_STAGE(PG8_SA(0, 0), a2, voffA);
            PG8_BAR; PG8_WAIT_L(0); PG8_MMA(1, 0, At, B0); PG8_BAR; PG8_SCHED;
            PG8_STAGE(PG8_SB(0, 1), b2 + hstep, voffB);
            PG8_WAIT_V(6); PG8_BAR; PG8_MMA(1, 1, At, B1); PG8_BAR;
            PG8_LDB(B0, 1, 0); PG8_SCHED; PG8_LDA(At, 1, 0); PG8_STAGE(PG8_SA(0, 1), a2 + hstep, voffA);
            PG8_WAIT_L(8); PG8_BAR; PG8_WAIT_L(0); PG8_MMA(0, 0, At, B0); PG8_BAR; PG8_SCHED;
            PG8_LDB(B1, 1, 1); PG8_STAGE(PG8_SB(1, 0), b3, voffB);
            PG8_BAR; PG8_WAIT_L(0); PG8_MMA(0, 1, At, B1); PG8_BAR;
            PG8_LDA(At, 1, 1); PG8_STAGE(PG8_SA(1, 0), a3, voffA);
            PG8_BAR; PG8_WAIT_L(0); PG8_MMA(1, 0, At, B0); PG8_BAR; PG8_SCHED;
            PG8_STAGE(PG8_SB(1, 1), b3 + hstep, voffB);
            PG8_WAIT_V(6); PG8_BAR; PG8_MMA(1, 1, At, B1); PG8_BAR;
            }
        }
        if constexpr (ALIGN_EPI) { if (wr == 0) PG8_BAR; }
        if constexpr (!Epi::AFTER_DRAIN) { E(acc, cur, wr, wc, fr, fq); S.done(cur); }
        if (!has_next) break;
#pragma unroll
        for (int a = 0; a < 2; ++a)
#pragma unroll
            for (int b = 0; b < 2; ++b)
#pragma unroll
                for (int m = 0; m < 4; ++m)
#pragma unroll
                    for (int n = 0; n < 2; ++n) acc[a][b][m][n] = (f32x4){0.f, 0.f, 0.f, 0.f};
        cur = nxt; cA = nA; cB = nB; ++ui;
        if constexpr (ALIGN_EPI) { if (wr == 1) PG8_BAR; }
    }
    PG8_WAIT_V(0);
    if constexpr (!ALIGN_EPI) { if (wr == 0) PG8_BAR; }
    PG8_BAR;
    if constexpr (Epi::AFTER_DRAIN) { E.fused(acc, cur, wr, wc, fr, fq, lds, wid, lane); S.done(cur); }
#undef PG8_SA
#undef PG8_SB
#undef PG8_STAGE
#undef PG8_LDA
#undef PG8_LDB
#undef PG8_MMA
#undef PG8_WAIT_V
#undef PG8_WAIT_L
#undef PG8_BAR
#undef PG8_SCHED
}
}
#define GAS __attribute__((address_space(1)))
#define LAS __attribute__((address_space(3)))
typedef unsigned short bf16;
typedef unsigned v4u __attribute__((ext_vector_type(4)));
typedef float f32x4 __attribute__((ext_vector_type(4)));
typedef short bf16x8 __attribute__((ext_vector_type(8)));
typedef GAS unsigned gu32;
typedef GAS unsigned long long gu64;
#define RLX_AGENT __ATOMIC_RELAXED, __HIP_MEMORY_SCOPE_AGENT
#define LDS_WAIT() asm volatile("s_waitcnt lgkmcnt(0)" ::: "memory")
#define VM_WAIT() asm volatile("s_waitcnt vmcnt(0)" ::: "memory")
__device__ __forceinline__ unsigned long long rt() { return __builtin_amdgcn_s_memrealtime(); }
__device__ __forceinline__ unsigned f2bf(float f) { unsigned u = __builtin_bit_cast(unsigned, f); return (u + 0x7fffu + ((u >> 16) & 1u)) >> 16; }
__device__ __forceinline__ unsigned pk2(float lo, float hi) { return f2bf(lo) | (f2bf(hi) << 16); }

#define XB_TMO      128
#define XB_XCNT(j)  (256  + 64 * (j))
#define XB_XSUB(j)  (1280 + 64 * (j))
#define XB_XGEN(j)  (2304 + 64 * (j))
#define XB_TOP      3328
#define XB_TOPGEN   3392
#define XCD_BAR_WORDS 3456
#define XB_SPIN_CAP (1u << 18)

__device__ __forceinline__ unsigned xb_ld(unsigned* p)              { return __hip_atomic_load(p, __ATOMIC_RELAXED, __HIP_MEMORY_SCOPE_AGENT); }
__device__ __forceinline__ unsigned xb_add(unsigned* p, unsigned v) { return __hip_atomic_fetch_add(p, v, __ATOMIC_RELAXED, __HIP_MEMORY_SCOPE_AGENT); }
__device__ __forceinline__ unsigned xb_xcc_id() { return (unsigned)__builtin_amdgcn_s_getreg((3 << 11) | 20) & 0xFu; }
#define XB_SPIN(cond, bar) do { unsigned _sp = 0; while (cond) { __builtin_amdgcn_s_sleep(1); \
    if ((++_sp & 255u) == 0u) { if (xb_ld(&(bar)[XB_TMO])) break; if (_sp > XB_SPIN_CAP) { atomicAdd(&(bar)[XB_TMO], 1u); break; } } } } while (0)

struct XcdBarrier {
    unsigned* bar; unsigned x;
    volatile LAS unsigned* st;
};

__device__ __forceinline__ XcdBarrier xcd_barrier_post(unsigned* bar, volatile LAS unsigned* st) {
    XcdBarrier b; b.bar = bar; b.x = xb_xcc_id(); b.st = st;
    if (threadIdx.x == 0) (void)xb_add(&bar[XB_XCNT(b.x)], 1u);
    return b;
}
__device__ __forceinline__ void xcd_barrier_complete(unsigned* bar, unsigned x, unsigned& nloc, unsigned& nx) {
    const unsigned G = gridDim.x * gridDim.y * gridDim.z;
    unsigned sum, cnt, mine, sp = 0u;
    for (;;) {
        sum = 0u; cnt = 0u; mine = 0u;
#pragma unroll
        for (unsigned j = 0; j < 16; ++j) { const unsigned c = xb_ld(&bar[XB_XCNT(j)]); sum += c; cnt += (c > 0u) ? 1u : 0u; mine = (j == x) ? c : mine; }
        if (sum == G) break;
        __builtin_amdgcn_s_sleep(1);
        if ((++sp & 255u) == 0u) { if (xb_ld(&bar[XB_TMO])) break; if (sp > XB_SPIN_CAP) { atomicAdd(&bar[XB_TMO], 1u); break; } }
    }
    nloc = mine > 0u ? mine : 1u; nx = cnt > 0u ? cnt : 1u;
}

__device__ __forceinline__ void xcd_barrier(const XcdBarrier& b) {
    asm volatile("s_waitcnt vmcnt(0)" ::: "memory");
    __syncthreads();
    if (threadIdx.x == 0) {
        unsigned* bar = b.bar;
        __builtin_amdgcn_s_waitcnt(0);
        unsigned nloc = b.st[0], nx = b.st[1];
        if (nloc == 0u) { xcd_barrier_complete(bar, b.x, nloc, nx); b.st[0] = nloc; b.st[1] = nx; }
        const unsigned old = xb_add(&bar[XB_XSUB(b.x)], 1u);
        const unsigned gen = old / nloc;
        if (old + 1u == (gen + 1u) * nloc) {
            __builtin_amdgcn_fence(__ATOMIC_RELEASE, "agent");
            asm volatile("s_waitcnt vmcnt(0)" ::: "memory");
            const unsigned og = xb_add(&bar[XB_TOP], 1u);
            const unsigned tg = og / nx;
            if (og + 1u == (tg + 1u) * nx) xb_add(&bar[XB_TOPGEN], 1u);
            else XB_SPIN(xb_ld(&bar[XB_TOPGEN]) == tg, bar);
            __builtin_amdgcn_fence(__ATOMIC_ACQUIRE, "agent");
            xb_add(&bar[XB_XGEN(b.x)], 1u);
            asm volatile("s_waitcnt vmcnt(0)" ::: "memory");
        } else {
            XB_SPIN(xb_ld(&bar[XB_XGEN(b.x)]) == gen, bar);
            __builtin_amdgcn_fence(__ATOMIC_ACQUIRE, "agent");
            asm volatile("s_waitcnt vmcnt(0)" ::: "memory");
        }
    }
    __syncthreads();
}

constexpr int NWAVES = 8;
#ifndef MK_N_LAUNCHES
#define MK_N_LAUNCHES 8
#endif
constexpr int N_LAUNCHES = MK_N_LAUNCHES;
constexpr int PER_PHASE = 8;
constexpr int MP = 65536, MS = 1024, MT = 66560, DM = 1024, PW = 5888, FF = 4096;
constexpr float EPS = 1e-6f, LOG2E = 1.4426950408889634f;
constexpr size_t MiB = 1u << 20;
constexpr size_t WS_CTL = 0, CTL_ZERO_BYTES = 1 * MiB;
constexpr size_t WS_WIN = 2 * MiB, WS_WAC = 14 * MiB, WS_WO = 16 * MiB, WS_W1 = 18 * MiB, WS_W2 = 26 * MiB;
constexpr size_t WS_RSTD0 = 34 * MiB, WS_SSQ1 = 35 * MiB, WS_BIAST = 45 * MiB;
constexpr size_t WS_XB = 48 * MiB;
constexpr size_t WS_PROJ = 178 * MiB;
constexpr size_t WS_AB = 926 * MiB;
constexpr size_t WS_MB = 1024 * MiB;
constexpr size_t WS_X1 = 1154 * MiB;
constexpr size_t WS_END = 1414 * MiB;
static_assert(WS_WIN + (size_t)PW * DM * 2 <= WS_WAC && WS_SSQ1 + (size_t)MT * 64 <= WS_BIAST && WS_XB + (size_t)MT * DM * 2 <= WS_PROJ && WS_PROJ + (size_t)MT * PW * 2 <= WS_AB && WS_AB + (size_t)MT * 768 * 2 <= WS_MB && WS_MB + (size_t)MT * DM * 2 <= WS_X1 && WS_X1 + (size_t)MT * DM * 4 <= WS_END, "d_ws map");
constexpr int CW_BAR = 4096;
constexpr int RING_OFF = 0, RING_BYTES = 131072;
constexpr int LDSCTL_OFF = RING_BYTES, MISC_OFF = LDSCTL_OFF + 320;
constexpr int LDS_BYTES = 147456;
static_assert(MISC_OFF + 128 <= LDS_BYTES, "LDS map");

__constant__ unsigned char BUCKETS[3][132] = {
 {0,1,2,3,4,5,6,7,8,9,10,11,12,13,14,15,16,16,16,16,16,16,17,17,17,17,17,17,17,17,18,18,18,18,18,18,18,18,18,18,19,19,19,19,19,19,19,19,19,19,19,19,19,19,20,20,20,20,20,20,20,20,20,20,20,20,20,20,20,20,20,20,20,21,21,21,21,21,21,21,21,21,21,21,21,21,21,21,21,21,21,21,21,21,21,21,21,21,21,22,22,22,22,22,22,22,22,22,22,22,22,22,22,22,22,22,22,22,22,22,22,22,22,22,22,22,22,22,22,0,0,0},
 {0,4,8,12,16,16,17,17,18,18,19,19,19,19,20,20,20,20,20,21,21,21,21,21,21,22,22,22,22,22,22,22,22,22,23,23,23,23,23,23,23,23,23,23,23,23,24,24,24,24,24,24,24,24,24,24,24,24,24,24,24,24,25,25,25,25,25,25,25,25,25,25,25,25,25,25,25,25,25,25,25,25,25,26,26,26,26,26,26,26,26,26,26,26,26,26,26,26,26,26,26,26,26,26,26,26,26,26,26,26,26,26,26,27,27,27,27,27,27,27,27,27,27,27,27,27,27,27,27,0,0,0},
 {0,16,18,19,20,21,21,22,22,23,23,23,24,24,24,24,25,25,25,25,25,26,26,26,26,26,26,26,26,27,27,27,27,27,27,27,27,27,27,28,28,28,28,28,28,28,28,28,28,28,28,28,29,29,29,29,29,29,29,29,29,29,29,29,29,29,29,29,29,29,30,30,30,30,30,30,30,30,30,30,30,30,30,30,30,30,30,30,30,30,30,30,30,30,30,31,31,31,31,31,31,31,31,31,31,31,31,31,31,31,31,31,31,31,31,31,31,31,31,31,31,31,31,31,31,31,31,31,31,0,0,0}};

struct Frame {
    LAS unsigned char* lds;
    volatile LAS unsigned* MISC;
    gu32* ctl;
    int tid, lane, wave;
    int vcu, G;
    const float *xp, *xs, *cache[3], *sconv, *w_in, *w_ao, *w_co, *w_o, *conv_w, *conv_b, *rel_bias, *g_mix, *g_mlp, *w_ff1, *w_ff2, *g_fin;
    float* out;
    bf16 *WIN_T, *WAC_T, *WO_T, *W1_T, *W2_T, *XB, *PROJ, *AB, *MB;
    float *RSTD0, *SSQ1, *BIAST, *X1;
};

__device__ __forceinline__ float wave_sum(float v) {
#pragma unroll
    for (int o = 1; o < 64; o <<= 1) v += __shfl_xor(v, o);
    return v;
}
__device__ __forceinline__ void p0_transpose_item(const float* W, int N, bf16* WT, int ldT, int koff, const float* kscale, LAS float* scr, int item, int lane) {
    const int nblk = N / 32, kb = item / nblk, nb = item % nblk, k0 = 64 * kb, n0 = 32 * nb;
#pragma unroll 8
    for (int i = 0; i < 32; ++i) { const int kk = 2 * i + (lane >> 5); const float sc = kscale ? kscale[k0 + kk] : 1.f; scr[kk * 33 + (lane & 31)] = W[(size_t)(k0 + kk) * N + n0 + (lane & 31)] * sc; }
    LDS_WAIT(); asm volatile("" ::: "memory");
    const int c = lane & 7;
#pragma unroll
    for (int j = 0; j < 4; ++j) { const int n = (lane >> 3) + 8 * j; const LAS float* s = scr + (8 * c) * 33 + n;
        v4u o; o.x = pk2(s[0 * 33], s[1 * 33]); o.y = pk2(s[2 * 33], s[3 * 33]); o.z = pk2(s[4 * 33], s[5 * 33]); o.w = pk2(s[6 * 33], s[7 * 33]);
        *(GAS v4u*)(WT + (size_t)(n0 + n) * ldT + koff + k0 + 8 * c) = o; }
    LDS_WAIT(); asm volatile("" ::: "memory");
}
__device__ __forceinline__ void p0_row(Frame& F, const float* xrow, bf16* orow, float* rstd) {
    const GAS f32x4* xr = (const GAS f32x4*)xrow + F.lane;
    f32x4 v[4]; float s = 0.f;
#pragma unroll
    for (int j = 0; j < 4; ++j) { v[j] = xr[64 * j]; s += (v[j].x * v[j].x + v[j].y * v[j].y) + (v[j].z * v[j].z + v[j].w * v[j].w); }
    const float tot = wave_sum(s);
    GAS unsigned long long* o8 = (GAS unsigned long long*)orow + F.lane;
#pragma unroll
    for (int j = 0; j < 4; ++j) o8[64 * j] = (unsigned long long)pk2(v[j].x, v[j].y) | ((unsigned long long)pk2(v[j].z, v[j].w) << 32);
    if (F.lane == 0) *rstd = 1.0f / sqrtf(tot * (1.f / DM) + EPS);
}
__device__ __forceinline__ void p0_prologue(Frame& F) {
    LAS float* scr = (LAS float*)(F.lds + RING_OFF + F.wave * 16384);
    const int gw = F.vcu * NWAVES + F.wave, NGW = F.G * NWAVES;
    constexpr int I_IN = (DM / 64) * (PW / 32), I_AO = (256 / 64) * (DM / 32), I_CO = (512 / 64) * (DM / 32), I_O = (DM / 64) * (DM / 32), I_1 = (DM / 64) * (FF / 32), I_2 = (FF / 64) * (DM / 32);
    constexpr int NITEMS = I_IN + I_AO + I_CO + I_O + I_1 + I_2;
    for (int it = gw; it < NITEMS; it += NGW) {
        int r = it;
        if (r < I_IN) { p0_transpose_item(F.w_in, PW, F.WIN_T, DM, 0, F.g_mix, scr, r, F.lane); continue; } r -= I_IN;
        if (r < I_AO) { p0_transpose_item(F.w_ao, DM, F.WAC_T, 768, 0, nullptr, scr, r, F.lane); continue; } r -= I_AO;
        if (r < I_CO) { p0_transpose_item(F.w_co, DM, F.WAC_T, 768, 256, nullptr, scr, r, F.lane); continue; } r -= I_CO;
        if (r < I_O) { p0_transpose_item(F.w_o, DM, F.WO_T, DM, 0, nullptr, scr, r, F.lane); continue; } r -= I_O;
        if (r < I_1) { p0_transpose_item(F.w_ff1, FF, F.W1_T, DM, 0, F.g_mlp, scr, r, F.lane); continue; } r -= I_1;
        p0_transpose_item(F.w_ff2, DM, F.W2_T, FF, 0, nullptr, scr, r, F.lane);
    }
    for (int m = gw; m < MT; m += NGW) p0_row(F, m < MP ? F.xp + (size_t)m * DM : F.xs + (size_t)(m - MP) * DM, F.XB + (size_t)m * DM, F.RSTD0 + m);
    for (int i = gw * 64 + F.lane; i < 12 * 132; i += NGW * 64) { const int gh = i / 132, j = i % 132, g = gh >> 2; F.BIAST[i] = j <= 128 ? F.rel_bias[(int)BUCKETS[g][j] * 12 + gh] * LOG2E : 0.f; }
}

__device__ __forceinline__ void ld_bf4(const bf16* p, float& a, float& b, float& c, float& d) { const uint2 w = *(const uint2*)p; a = __uint_as_float(w.x << 16); b = __uint_as_float(w.x & 0xffff0000u); c = __uint_as_float(w.y << 16); d = __uint_as_float(w.y & 0xffff0000u); }
__device__ __forceinline__ void ld_bf8(const bf16* p, float (&o)[8]) { const v4u w = *(const v4u*)p;
#pragma unroll
    for (int i = 0; i < 4; ++i) { o[2 * i] = __uint_as_float(w[i] << 16); o[2 * i + 1] = __uint_as_float(w[i] & 0xffff0000u); } }
__device__ __forceinline__ void p2_token(Frame& F, int R) {
    const int l = F.lane, h = l >> 4;
    const bool samp = R >= MP;
    const int b = samp ? (R - MP) >> 3 : R >> 13, t = samp ? (R - MP) & 7 : R & 8191;
    float mx = -1e30f, ls = 0.f, o0 = 0.f, o1 = 0.f, o2 = 0.f, o3 = 0.f;
    for (int g = 0; g < 3; ++g) {
        const int dil = 1 << (2 * g), win = 128 << (2 * g);
        float q0, q1, q2, q3; ld_bf4(F.PROJ + (size_t)R * PW + g * 256 + 4 * l, q0, q1, q2, q3);
        const float* bias = F.BIAST + (g * 4 + h) * 132;
        const float* cache = (g == 0 ? F.cache[0] : (g == 1 ? F.cache[1] : F.cache[2])) + (size_t)b * win * 512;
        for (int j0 = 0; j0 < 132; j0 += 4) {
            if (!samp && t - j0 * dil < 0) break;
            float s[4], v[4][4];
#pragma unroll
            for (int u = 0; u < 4; ++u) {
                const int j = j0 + u;
                const bool valid = (j <= 128) && (samp || t - j * dil >= 0);
                const int jj = valid ? j : 0;
                float k0, k1, k2, k3;
                bool from_proj = true; int prow = R - jj * dil;
                if (samp) { const int pos = win + t - jj * dil; if (pos >= win) prow = MP + b * 8 + (pos - win); else { from_proj = false; prow = pos; } }
                if (from_proj) { const bf16* kp = F.PROJ + (size_t)prow * PW + 768 + g * 256 + 4 * l; ld_bf4(kp, k0, k1, k2, k3); ld_bf4(kp + 768, v[u][0], v[u][1], v[u][2], v[u][3]); }
                else { const float* kp = cache + (size_t)prow * 512 + 4 * l; const f32x4 kk = *(const f32x4*)kp, vv = *(const f32x4*)(kp + 256); k0 = kk.x; k1 = kk.y; k2 = kk.z; k3 = kk.w; v[u][0] = vv.x; v[u][1] = vv.y; v[u][2] = vv.z; v[u][3] = vv.w; }
                float p = (q0 * k0 + q1 * k1) + (q2 * k2 + q3 * k3);
                p += __shfl_xor(p, 1); p += __shfl_xor(p, 2); p += __shfl_xor(p, 4); p += __shfl_xor(p, 8);
                s[u] = valid ? p + bias[j] : -INFINITY;
            }
            const float mn = fmaxf(fmaxf(mx, fmaxf(s[0], s[1])), fmaxf(s[2], s[3]));
            const float al = __builtin_amdgcn_exp2f(mx - mn);
            float p0 = __builtin_amdgcn_exp2f(s[0] - mn), p1 = __builtin_amdgcn_exp2f(s[1] - mn), p2 = __builtin_amdgcn_exp2f(s[2] - mn), p3 = __builtin_amdgcn_exp2f(s[3] - mn);
            ls = ls * al + ((p0 + p1) + (p2 + p3));
            o0 = o0 * al + ((p0 * v[0][0] + p1 * v[1][0]) + (p2 * v[2][0] + p3 * v[3][0]));
            o1 = o1 * al + ((p0 * v[0][1] + p1 * v[1][1]) + (p2 * v[2][1] + p3 * v[3][1]));
            o2 = o2 * al + ((p0 * v[0][2] + p1 * v[1][2]) + (p2 * v[2][2] + p3 * v[3][2]));
            o3 = o3 * al + ((p0 * v[0][3] + p1 * v[1][3]) + (p2 * v[2][3] + p3 * v[3][3]));
            mx = mn;
        }
    }
    const float inv = 1.f / ls;
    *(uint2*)(F.AB + (size_t)R * 768 + 4 * l) = make_uint2(pk2(o0 * inv, o1 * inv), pk2(o2 * inv, o3 * inv));
    const int c = 8 * l;
    const bf16* pr = F.PROJ + (size_t)R * PW + c;
    float cb[8], cc[8], ch[8], u0[8], u1[8], u2[8];
    ld_bf8(pr + 2304, cb); ld_bf8(pr + 2816, cc); ld_bf8(pr + 3328, ch);
#pragma unroll
    for (int i = 0; i < 8; ++i) u0[i] = cc[i] * ch[i];
    if (t >= 1) { ld_bf8(pr - PW + 2816, cc); ld_bf8(pr - PW + 3328, ch);
#pragma unroll
        for (int i = 0; i < 8; ++i) u1[i] = cc[i] * ch[i]; }
    else if (samp) { const f32x4 a = *(const f32x4*)(F.sconv + (size_t)(b * 2 + 1) * 512 + c), d = *(const f32x4*)(F.sconv + (size_t)(b * 2 + 1) * 512 + c + 4);
        u1[0] = a.x; u1[1] = a.y; u1[2] = a.z; u1[3] = a.w; u1[4] = d.x; u1[5] = d.y; u1[6] = d.z; u1[7] = d.w; }
    else {
#pragma unroll
        for (int i = 0; i < 8; ++i) u1[i] = 0.f; }
    if (t >= 2) { ld_bf8(pr - 2 * PW + 2816, cc); ld_bf8(pr - 2 * PW + 3328, ch);
#pragma unroll
        for (int i = 0; i < 8; ++i) u2[i] = cc[i] * ch[i]; }
    else if (samp) { const f32x4 a = *(const f32x4*)(F.sconv + (size_t)(b * 2 + t) * 512 + c), d = *(const f32x4*)(F.sconv + (size_t)(b * 2 + t) * 512 + c + 4);
        u2[0] = a.x; u2[1] = a.y; u2[2] = a.z; u2[3] = a.w; u2[4] = d.x; u2[5] = d.y; u2[6] = d.z; u2[7] = d.w; }
    else {
#pragma unroll
        for (int i = 0; i < 8; ++i) u2[i] = 0.f; }
    float z[8];
#pragma unroll
    for (int i = 0; i < 8; ++i) z[i] = cb[i] * (F.conv_b[c + i] + F.conv_w[c + i] * u2[i] + F.conv_w[512 + c + i] * u1[i] + F.conv_w[1024 + c + i] * u0[i]);
    v4u w; w.x = pk2(z[0], z[1]); w.y = pk2(z[2], z[3]); w.z = pk2(z[4], z[5]); w.w = pk2(z[6], z[7]);
    *(v4u*)(F.AB + (size_t)R * 768 + 256 + c) = w;
    float* cs = nullptr;
    if (!samp && t >= 8190) cs = F.out + pg8::O_CONVP + (size_t)(b * 2 + (t - 8190)) * 512 + c;
    if (samp && t >= 6) cs = F.out + pg8::O_CONVS + (size_t)(b * 2 + (t - 6)) * 512 + c;
    if (cs) { *(f32x4*)cs = (f32x4){u0[0], u0[1], u0[2], u0[3]}; *(f32x4*)(cs + 4) = (f32x4){u0[4], u0[5], u0[6], u0[7]}; }
}
__device__ __forceinline__ void p7_row(Frame& F, float* row) {
    GAS f32x4* xr = (GAS f32x4*)row + F.lane;
    f32x4 v[4]; float s = 0.f;
#pragma unroll
    for (int j = 0; j < 4; ++j) { v[j] = xr[64 * j]; s += (v[j].x * v[j].x + v[j].y * v[j].y) + (v[j].z * v[j].z + v[j].w * v[j].w); }
    const float rs = 1.0f / sqrtf(wave_sum(s) * (1.f / DM) + EPS);
#pragma unroll
    for (int j = 0; j < 4; ++j) { const f32x4 g = *((const f32x4*)F.g_fin + F.lane + 64 * j); xr[64 * j] = v[j] * rs * g; }
}

struct Args { const float* in[18]; float* out; unsigned char* ws; int ph_lo, ph_hi, li, pad; };
__global__ void __launch_bounds__(NWAVES * 64, 2) mk_fwd(Args args) {
    extern __shared__ __attribute__((aligned(16))) unsigned char lds[];
    Frame F;
    F.lds = (LAS unsigned char*)lds;
    F.MISC = (volatile LAS unsigned*)(F.lds + MISC_OFF);
    F.tid = threadIdx.x; F.lane = F.tid & 63; F.wave = __builtin_amdgcn_readfirstlane(F.tid >> 6);
    F.G = gridDim.x; { const int bx = blockIdx.x; F.vcu = (F.G % 8 == 0) ? (bx % 8) * (F.G / 8) + bx / 8 : bx; }
    unsigned char* ws = args.ws;
    F.ctl = (gu32*)(ws + WS_CTL);
    F.xp = args.in[0]; F.xs = args.in[1]; F.cache[0] = args.in[2]; F.cache[1] = args.in[3]; F.cache[2] = args.in[4]; F.sconv = args.in[5];
    F.w_in = args.in[6]; F.w_ao = args.in[7]; F.w_co = args.in[8]; F.w_o = args.in[9]; F.conv_w = args.in[10]; F.conv_b = args.in[11]; F.rel_bias = args.in[12];
    F.g_mix = args.in[13]; F.g_mlp = args.in[14]; F.w_ff1 = args.in[15]; F.w_ff2 = args.in[16]; F.g_fin = args.in[17];
    F.out = args.out;
    F.WIN_T = (bf16*)(ws + WS_WIN); F.WAC_T = (bf16*)(ws + WS_WAC); F.WO_T = (bf16*)(ws + WS_WO); F.W1_T = (bf16*)(ws + WS_W1); F.W2_T = (bf16*)(ws + WS_W2);
    F.XB = (bf16*)(ws + WS_XB); F.PROJ = (bf16*)(ws + WS_PROJ); F.AB = (bf16*)(ws + WS_AB); F.MB = (bf16*)(ws + WS_MB);
    F.RSTD0 = (float*)(ws + WS_RSTD0); F.SSQ1 = (float*)(ws + WS_SSQ1); F.BIAST = (float*)(ws + WS_BIAST); F.X1 = (float*)(ws + WS_X1);
    for (int u = F.tid; u < (LDS_BYTES - LDSCTL_OFF) / 4; u += NWAVES * 64) ((LAS unsigned*)(F.lds + LDSCTL_OFF))[u] = 0u;
    __syncthreads();
    XcdBarrier bar; bar.bar = (unsigned*)(F.ctl + CW_BAR); bar.x = 0; bar.st = nullptr;
    if (N_LAUNCHES != PER_PHASE) bar = xcd_barrier_post((unsigned*)(F.ctl + CW_BAR), F.MISC + 8);
#define GRID_BAR() do { if (N_LAUNCHES != PER_PHASE) xcd_barrier(bar); } while (0)
    const int lo = args.ph_lo, hi = args.ph_hi;
#define IN(k) (lo <= (k) && (k) < hi)
#define BOTH(k) (IN(k) && IN((k) + 1))
    const int gw = F.vcu * NWAVES + F.wave, NGW = F.G * NWAVES;

    if (IN(0)) { p0_prologue(F); if (BOTH(0)) GRID_BAR(); }
    if (IN(1)) {
        pg8::Gemm g{F.XB, F.WIN_T, MT, PW, DM}; pg8::StaticOrder S; S.init(MT, PW, F.G, (int)blockIdx.x);
        pg8::EpiProj E{F.PROJ, F.RSTD0, F.out};
        pg8::gemm_phase<pg8::EpiProj, pg8::StaticOrder, true, true>(F.lds + RING_OFF, g, S, E);
        if (BOTH(1)) GRID_BAR();
    }
    if (IN(2)) {
        for (int R = gw; R < MT; R += NGW) p2_token(F, R);
        if (BOTH(2)) GRID_BAR();
    }
    if (IN(3)) {
        pg8::Gemm g{F.AB, F.WAC_T, MT, DM, 768}; pg8::StaticOrder S; S.init(MT, DM, F.G, (int)blockIdx.x);
        pg8::EpiGate E{F.MB, F.PROJ};
        pg8::gemm_phase<pg8::EpiGate, pg8::StaticOrder, true, true>(F.lds + RING_OFF, g, S, E);
        if (BOTH(3)) GRID_BAR();
    }
    if (IN(4)) {
        pg8::Gemm g{F.MB, F.WO_T, MT, DM, DM}; pg8::StaticOrder S; S.init(MT, DM, F.G, (int)blockIdx.x);
        pg8::EpiRes1 E{F.xp, F.xs, F.X1, F.XB, F.SSQ1};
        pg8::gemm_phase<pg8::EpiRes1, pg8::StaticOrder, true, true>(F.lds + RING_OFF, g, S, E);
        if (BOTH(4)) GRID_BAR();
    }
    if (IN(5)) {
        pg8::Gemm g{F.XB, F.W1_T, MT, FF, DM}; pg8::StaticOrder S; S.init(MT, FF, F.G, (int)blockIdx.x);
        pg8::EpiFF1 E{F.PROJ, F.SSQ1};
        pg8::gemm_phase<pg8::EpiFF1, pg8::StaticOrder, true, true>(F.lds + RING_OFF, g, S, E);
        if (BOTH(5)) GRID_BAR();
    }
    if (IN(6)) {
        pg8::Gemm g{F.PROJ, F.W2_T, MT, DM, FF}; pg8::StaticOrder S; S.init(MT, DM, F.G, (int)blockIdx.x);
        pg8::EpiRes2 E{F.X1, F.out};
        pg8::gemm_phase<pg8::EpiRes2, pg8::StaticOrder, true, true>(F.lds + RING_OFF, g, S, E);
        if (BOTH(6)) GRID_BAR();
    }
    if (IN(7)) { for (int m = gw; m < MT; m += NGW) p7_row(F, F.out + (size_t)m * DM); }
#undef IN
#undef BOTH
}

extern "C" void kernel_launch(void* const* d_in, const int* in_sizes, int n_in, void* d_out, int out_size, void* d_ws, size_t ws_size, hipStream_t stream) {
    static int grid = 0;
    if (grid == 0) {
        if (n_in != 18 || in_sizes[0] != MP * DM || (size_t)out_size != pg8::O_END || ws_size < WS_END) { fprintf(stderr, "kernel_launch: unexpected shapes: n_in %d in0 %d out %d ws %zu (need %zu)\n", n_in, n_in > 0 ? in_sizes[0] : -1, out_size, ws_size, (size_t)WS_END); grid = -1; return; }
        int dev = 0, cus = 0, per_cu = 0;
        if (hipGetDevice(&dev) != hipSuccess || hipDeviceGetAttribute(&cus, hipDeviceAttributeMultiprocessorCount, dev) != hipSuccess) { fprintf(stderr, "kernel_launch: device query failed\n"); grid = -1; return; }
        if (hipFuncSetAttribute((const void*)mk_fwd, hipFuncAttributeMaxDynamicSharedMemorySize, LDS_BYTES) != hipSuccess) { fprintf(stderr, "kernel_launch: hipFuncSetAttribute failed\n"); grid = -1; return; }
        if (hipOccupancyMaxActiveBlocksPerMultiprocessor(&per_cu, (const void*)mk_fwd, NWAVES * 64, LDS_BYTES) != hipSuccess || per_cu < 1) { fprintf(stderr, "kernel_launch: occupancy query reports %d blocks per CU\n", per_cu); }
        (void)hipGetLastError();
        grid = cus;
    }
    if (grid < 0) return;
    if (hipMemsetAsync((char*)d_ws + WS_CTL, 0, CTL_ZERO_BYTES, stream) != hipSuccess) { fprintf(stderr, "kernel_launch: memset failed\n"); return; }
    Args a{};
    for (int i = 0; i < 18; ++i) a.in[i] = (const float*)d_in[i];
    a.out = (float*)d_out; a.ws = (unsigned char*)d_ws;
    for (int li = 0; li < N_LAUNCHES; ++li) {
        a.ph_lo = (N_LAUNCHES == PER_PHASE) ? li : 0; a.ph_hi = (N_LAUNCHES == PER_PHASE) ? li + 1 : PER_PHASE; a.li = li;
        hipLaunchKernelGGL(mk_fwd, dim3(grid), dim3(NWAVES * 64), LDS_BYTES, stream, a);
        const hipError_t le = hipPeekAtLastError();
        if (le != hipSuccess) { fprintf(stderr, "kernel_launch: launch %d failed: %s\n", li, hipGetErrorName(le)); break; }
    }
}
```

```cpp
#include <hip/hip_runtime.h>
#include <cstdio>
#include <cstdint>
namespace pg8 {
#define PG8_LAS __attribute__((address_space(3)))
typedef unsigned short bf16_t;
typedef short bf16x8 __attribute__((ext_vector_type(8)));
typedef float f32x4 __attribute__((ext_vector_type(4)));
typedef unsigned u32x4 __attribute__((ext_vector_type(4)));
constexpr int BM = 256, BK = 64, HALF = 128, HTB = HALF * BK * 2  , STAGE_BYTES = 8 * HTB, NXCD = 8, WGM = 8;

__host__ __device__ __forceinline__ int lds_byte(int r, int c) { const int st = (r >> 4) * 2 + (c >> 5), rr = r & 15, cc = c & 31, ob = rr * 64 + cc * 2; return st * 1024 + (ob ^ (((ob >> 9) & 1) << 5)); }
__host__ __device__ __forceinline__ void stage_rc(int b, int& R, int& C) { const int st = b / 1024, sb = b % 1024, swz = sb ^ (((sb >> 9) & 1) << 5); R = (st >> 1) * 16 + swz / 64; C = (st & 1) * 32 + (swz % 64) / 2; }
__host__ __device__ __forceinline__ int sigma0(int R) { return (R >> 5) * 64 + ((R & 15) >> 2) * 8 + ((R >> 4) & 1) * 4 + (R & 3); }
__host__ __device__ __forceinline__ int perm32(int rho) { const int n = rho >> 4, i = rho & 15; return 8 * (i >> 2) + 4 * n + (i & 3); }

struct Unit { int pm, pn; };
struct Gemm { const bf16_t* A; const bf16_t* Bt; int M, N, K; int pm_mask = -1, pn_mask = -1; };

struct StaticOrder {
    int nM, nN, nwg, G, c, reps;
    __host__ __device__ void init(int M, int N, int G_, int c_, int reps_ = 1) { nM = M / BM; nN = N / BM; nwg = nM * nN; G = G_; c = c_; reps = reps_; }
    __host__ __device__ bool next(int i, Unit& u) const {
        long L = (long)i * G + c; if (L >= (long)nwg * reps) return false; if (L >= nwg) L %= nwg;
        int wgid = (int)L; { const int q = nwg / NXCD, r = nwg % NXCD, xcd = wgid % NXCD, off = wgid / NXCD; wgid = (xcd < r ? xcd * (q + 1) : r * (q + 1) + (xcd - r) * q) + off; }
        const int nig = WGM * nN, gid = wgid / nig, fm = gid * WGM, gsz = (nM - fm) < WGM ? (nM - fm) : WGM;
        u.pm = fm + ((wgid % nig) % gsz); u.pn = (wgid % nig) / gsz; return true;
    }
    __device__ __forceinline__ void a_ready(const Unit&) const {}
    __device__ __forceinline__ void done(const Unit&) const {}
};

__device__ __forceinline__ unsigned cvt_pk_bf16(float lo, float hi) { unsigned r; asm volatile("v_cvt_pk_bf16_f32 %0, %1, %2" : "=v"(r) : "v"(lo), "v"(hi)); return r; }
typedef float f32x2 __attribute__((ext_vector_type(2)));
typedef unsigned u32x4_t __attribute__((ext_vector_type(4)));
__device__ __forceinline__ void xpose_out(PG8_LAS unsigned char* st, int fr, int fq, const u32x4_t& w0, const u32x4_t& w1, u32x4_t& o0, u32x4_t& o1) {
    const int sw = fr & 7, L = fq * 16 + fr, r0 = L >> 3, c = L & 7;
    *(PG8_LAS u32x4_t*)(st + fr * 128 + ((fq ^ sw) << 4)) = w0;
    *(PG8_LAS u32x4_t*)(st + fr * 128 + (((4 + fq) ^ sw) << 4)) = w1;
    o0 = *(const PG8_LAS u32x4_t*)(st + r0 * 128 + ((c ^ (r0 & 7)) << 4));
    o1 = *(const PG8_LAS u32x4_t*)(st + (r0 + 8) * 128 + ((c ^ (r0 & 7)) << 4));
}
__device__ __forceinline__ void xpose_in(PG8_LAS unsigned char* st, int fr, int fq, const u32x4_t& i0, const u32x4_t& i1, u32x4_t& w0, u32x4_t& w1) {
    const int sw = fr & 7, L = fq * 16 + fr, r0 = L >> 3, c = L & 7;
    *(PG8_LAS u32x4_t*)(st + r0 * 128 + ((c ^ (r0 & 7)) << 4)) = i0;
    *(PG8_LAS u32x4_t*)(st + (r0 + 8) * 128 + ((c ^ (r0 & 7)) << 4)) = i1;
    w0 = *(const PG8_LAS u32x4_t*)(st + fr * 128 + ((fq ^ sw) << 4));
    w1 = *(const PG8_LAS u32x4_t*)(st + fr * 128 + (((4 + fq) ^ sw) << 4));
}
typedef unsigned u32x2 __attribute__((ext_vector_type(2)));
constexpr int P_MP = 65536, P_MT = 66560, P_PW = 5888, P_D = 1024, P_FF = 4096;
constexpr float P_EPS = 1e-6f;
constexpr float P_QSCALE = 0.125f * 1.4426950408889634f;
constexpr size_t O_Y = 0, O_KVP0 = 68157440, O_KVP1 = 68681728, O_KVP2 = 70778880, O_CONVP = 79167488, O_KVS0 = 79175680, O_KVS1 = 79699968, O_KVS2 = 80224256, O_CONVS = 80748544, O_END = 80879616;
__device__ __forceinline__ float bf_lo(unsigned w) { return __uint_as_float(w << 16); }
__device__ __forceinline__ float bf_hi(unsigned w) { return __uint_as_float(w & 0xffff0000u); }

struct EpiProj {
    static constexpr bool PERM = true, AFTER_DRAIN = false, HAS_MID = false; static constexpr int MID_T = 0;
    float* out; bf16_t *QKV, *SQ, *CBU, *GT; PG8_LAS unsigned char* stg;
    __device__ __forceinline__ void operator()(const f32x4 (&acc)[2][2][4][2], const Unit& u, int wr, int wc, int fr, int fq) const {
        const int pn = u.pn;
        const int cin = wc * 64 + 8 * fq;
        PG8_LAS unsigned char* st = stg + (wr * 4 + wc) * 2048;
        const int L = fq * 16 + fr, r0 = L >> 3, cc8 = (L & 7) * 8;
        if (pn < 9) {
            const bool prompt = u.pm * BM < P_MP;
            const int cg = pn % 3, csh = 2 * cg;
            const float qs = (pn < 3) ? P_QSCALE : 1.f;
            const bool iskv = pn >= 3;
            const int kv = pn / 3 - 1, win = 128 << csh;
            const size_t okp = cg == 0 ? O_KVP0 : (cg == 1 ? O_KVP1 : O_KVP2), oks = cg == 0 ? O_KVS0 : (cg == 1 ? O_KVS1 : O_KVS2);
            bf16_t* const qkvh = QKV + (size_t)(pn / 3) * ((size_t)P_MP * 768) + cc8;
#pragma unroll
            for (int ai = 0; ai < 2; ++ai)
#pragma unroll
                for (int m = 0; m < 4; ++m) {
                    const int rowg = u.pm * BM + ai * HALF + wr * 64 + m * 16, row = rowg + fr;
                    float* kvp = nullptr;
                    if (iskv) {
                        if (!prompt) kvp = out + oks + ((size_t)(row - P_MP) * 2 + kv) * 256 + cin;
                        else { const int b = row >> 13, t = row & 8191; if (t >= 8192 - win) kvp = out + okp + ((size_t)(b * win + t - (8192 - win)) * 2 + kv) * 256 + cin; }
                    }
                    u32x4 w[2];
#pragma unroll
                    for (int bj = 0; bj < 2; ++bj) {
                        const f32x4 v0 = acc[ai][bj][m][0] * qs, v1 = acc[ai][bj][m][1] * qs;
                        w[bj].x = cvt_pk_bf16(v0[0], v0[1]); w[bj].y = cvt_pk_bf16(v0[2], v0[3]); w[bj].z = cvt_pk_bf16(v1[0], v1[1]); w[bj].w = cvt_pk_bf16(v1[2], v1[3]);
                        if (kvp) { *(f32x4*)(kvp + bj * 32) = v0; *(f32x4*)(kvp + bj * 32 + 4) = v1; }
                    }
                    u32x4 o[2]; xpose_out(st, fr, fq, w[0], w[1], o[0], o[1]);
#pragma unroll
                    for (int j = 0; j < 2; ++j) { const int R = rowg + r0 + 8 * j;
                        bf16_t* dst;
                        if (prompt) { const int b = R >> 13, t = R & 8191, cl = t & ((1 << csh) - 1), l = t >> csh;
                            dst = qkvh + ((size_t)((b * 3 + cg) * 4 + wc) * 8192 + (size_t)cl * (8192 >> csh) + l) * 64; }
                        else dst = SQ + (size_t)(R - P_MP) * 2304 + pn * BM + wc * 64 + cc8;
                        *(u32x4*)dst = o[j]; }
                }
        } else if (pn < 11) {
#pragma unroll
            for (int ai = 0; ai < 2; ++ai)
#pragma unroll
                for (int m = 0; m < 4; ++m) {
                    const int rowg = u.pm * BM + ai * HALF + wr * 64 + m * 16;
                    u32x4 w[2];
#pragma unroll
                    for (int bj = 0; bj < 2; ++bj) {
                        const f32x4 v0 = acc[ai][bj][m][0], v1 = acc[ai][bj][m][1];
                        w[bj].x = cvt_pk_bf16(v0[0], v0[1]); w[bj].y = cvt_pk_bf16(v0[2], v0[3]); w[bj].z = cvt_pk_bf16(v1[0], v1[1]); w[bj].w = cvt_pk_bf16(v1[2], v1[3]);
                    }
                    u32x4 o0, o1; xpose_out(st, fr, fq, w[0], w[1], o0, o1);
                    bf16_t* dst = CBU + (size_t)(rowg + r0) * 1024 + (pn - 9) * BM + wc * 64 + cc8;
                    *(u32x4*)dst = o0; *(u32x4*)(dst + 8 * 1024) = o1;
                }
        } else if (pn < 15) {
            const int uc = (pn - 11) * HALF + wc * 32 + 8 * fq;
#pragma unroll
            for (int ai = 0; ai < 2; ++ai)
#pragma unroll
                for (int m = 0; m < 4; ++m) {
                    const int row = u.pm * BM + ai * HALF + wr * 64 + m * 16 + fr;
                    const f32x4 v0 = acc[ai][0][m][0] * acc[ai][1][m][0], v1 = acc[ai][0][m][1] * acc[ai][1][m][1];
                    u32x4 w; w.x = cvt_pk_bf16(v0[0], v0[1]); w.y = cvt_pk_bf16(v0[2], v0[3]); w.z = cvt_pk_bf16(v1[0], v1[1]); w.w = cvt_pk_bf16(v1[2], v1[3]);
                    *(u32x4*)(CBU + (size_t)row * 1024 + 512 + uc) = w;
                    float* cs = nullptr;
                    if (row >= P_MP) { const int rr = row - P_MP, t = rr & 7; if (t >= 6) cs = out + O_CONVS + (size_t)((rr >> 3) * 2 + (t - 6)) * 512 + uc; }
                    else { const int t = row & 8191; if (t >= 8190) cs = out + O_CONVP + (size_t)((row >> 13) * 2 + (t - 8190)) * 512 + uc; }
                    if (cs) { *(f32x4*)cs = v0; *(f32x4*)(cs + 4) = v1; }
                }
        } else {
            const int q = pn - 15;
            bf16_t* gt = GT + (size_t)(u.pm * 4 + (q >> 1)) * 2 * 65536 + (size_t)((wr * 4 + wc) * 16 + (q & 1)) * 512 + (fq * 16 + fr) * 8;
#pragma unroll
            for (int ai = 0; ai < 2; ++ai)
#pragma unroll
                for (int m = 0; m < 4; ++m) {
                    const int rit = ai * HALF + wr * 64 + m * 16 + fr;
                    const float rs = -1.4426950408889634f;
                    float r[8], sg[8];
#pragma unroll
                    for (int n = 0; n < 2; ++n)
#pragma unroll
                        for (int i = 0; i < 4; ++i) {
                            const float ea = 1.f + __builtin_amdgcn_exp2f(acc[ai][0][m][n][i] * rs), eb = 1.f + __builtin_amdgcn_exp2f(acc[ai][1][m][n][i] * rs);
                            sg[4 * n + i] = __builtin_amdgcn_rcpf(eb); r[4 * n + i] = eb * __builtin_amdgcn_rcpf(ea);
                        }
                    u32x4 w; w.x = cvt_pk_bf16(r[0], r[1]); w.y = cvt_pk_bf16(r[2], r[3]); w.z = cvt_pk_bf16(r[4], r[5]); w.w = cvt_pk_bf16(r[6], r[7]);
                    *(u32x4*)(gt + (ai * 4 + m) * 1024) = w;
                    w.x = cvt_pk_bf16(sg[0], sg[1]); w.y = cvt_pk_bf16(sg[2], sg[3]); w.z = cvt_pk_bf16(sg[4], sg[5]); w.w = cvt_pk_bf16(sg[6], sg[7]);
                    *(u32x4*)(gt + 65536 + (ai * 4 + m) * 1024) = w;
                }
        }
    }
};

struct EpiGate {
    static constexpr bool PERM = true, AFTER_DRAIN = false, HAS_MID = true; static constexpr int MID_T = 4;
    bf16_t* Mo; const bf16_t* GT; PG8_LAS unsigned char* stg;
    __device__ __forceinline__ void mid(f32x4 (&acc)[2][2][4][2], const Unit& u, int wr, int wc, int fr, int fq) const {
        int lo = (fq * 16 + fr) * 8;
        asm volatile("" : "+v"(lo));
        const bf16_t* gp = GT + (size_t)(u.pm * 4 + u.pn) * 2 * 65536 + (size_t)(wr * 4 + wc) * 16 * 512 + lo;
        u32x4 rw[2][4][2];
#pragma unroll
        for (int ai = 0; ai < 2; ++ai)
#pragma unroll
            for (int m = 0; m < 4; ++m)
#pragma unroll
                for (int bj = 0; bj < 2; ++bj) rw[ai][m][bj] = *(const u32x4*)(gp + ((ai * 4 + m) * 2 + bj) * 512);
#pragma unroll
        for (int ai = 0; ai < 2; ++ai)
#pragma unroll
            for (int m = 0; m < 4; ++m)
#pragma unroll
                for (int bj = 0; bj < 2; ++bj) { const u32x4 a = rw[ai][m][bj];
                    acc[ai][bj][m][0] = acc[ai][bj][m][0] * (f32x4){bf_lo(a.x), bf_hi(a.x), bf_lo(a.y), bf_hi(a.y)};
                    acc[ai][bj][m][1] = acc[ai][bj][m][1] * (f32x4){bf_lo(a.z), bf_hi(a.z), bf_lo(a.w), bf_hi(a.w)}; }
    }
    __device__ __forceinline__ void operator()(const f32x4 (&acc)[2][2][4][2], const Unit& u, int wr, int wc, int fr, int fq) const {
        const bf16_t* gp = GT + ((size_t)(u.pm * 4 + u.pn) * 2 + 1) * 65536 + (size_t)(wr * 4 + wc) * 16 * 512 + (fq * 16 + fr) * 8;
        u32x4 sw[2][4][2];
#pragma unroll
        for (int ai = 0; ai < 2; ++ai)
#pragma unroll
            for (int m = 0; m < 4; ++m)
#pragma unroll
                for (int bj = 0; bj < 2; ++bj) sw[ai][m][bj] = *(const u32x4*)(gp + ((ai * 4 + m) * 2 + bj) * 512);
        PG8_LAS unsigned char* st = stg + (wr * 4 + wc) * 2048;
        const int L = fq * 16 + fr;
        bf16_t* ob = Mo + (size_t)(u.pm * BM + wr * 64 + (L >> 3)) * P_D + u.pn * BM + wc * 64 + (L & 7) * 8;
#pragma unroll
        for (int ai = 0; ai < 2; ++ai)
#pragma unroll
            for (int m = 0; m < 4; ++m) {
                u32x4 w[2];
#pragma unroll
                for (int bj = 0; bj < 2; ++bj) {
                    const u32x4 a = sw[ai][m][bj];
                    const f32x4 v0 = acc[ai][bj][m][0] * (f32x4){bf_lo(a.x), bf_hi(a.x), bf_lo(a.y), bf_hi(a.y)}, v1 = acc[ai][bj][m][1] * (f32x4){bf_lo(a.z), bf_hi(a.z), bf_lo(a.w), bf_hi(a.w)};
                    w[bj].x = cvt_pk_bf16(v0[0], v0[1]); w[bj].y = cvt_pk_bf16(v0[2], v0[3]); w[bj].z = cvt_pk_bf16(v1[0], v1[1]); w[bj].w = cvt_pk_bf16(v1[2], v1[3]);
                }
                u32x4 o0, o1; xpose_out(st, fr, fq, w[0], w[1], o0, o1);
                bf16_t* op = ob + (size_t)(ai * HALF + m * 16) * P_D;
                *(u32x4*)op = o0; *(u32x4*)(op + 8 * P_D) = o1;
            }
    }
};

struct EpiNone {
    static constexpr bool PERM = true, AFTER_DRAIN = false, HAS_MID = false; static constexpr int MID_T = 0;
    __device__ __forceinline__ void operator()(const f32x4 (&acc)[2][2][4][2], const Unit& u, int wr, int wc, int fr, int fq) const {
#pragma unroll
        for (int ai = 0; ai < 2; ++ai)
#pragma unroll
            for (int bj = 0; bj < 2; ++bj)
#pragma unroll
                for (int m = 0; m < 4; ++m)
#pragma unroll
                    for (int n = 0; n < 2; ++n) asm volatile("" :: "v"(acc[ai][bj][m][n]));
    }
};
template <int VAR = 0> struct EpiRes1T {
    static constexpr bool PERM = true, AFTER_DRAIN = false, HAS_MID = false; static constexpr int MID_T = 0;
    bf16_t* XB; float* ssq; const float* xnorm; PG8_LAS unsigned char* stg;
    __device__ __forceinline__ void operator()(const f32x4 (&acc)[2][2][4][2], const Unit& u, int wr, int wc, int fr, int fq) const {
        PG8_LAS unsigned char* st = stg + (wr * 4 + wc) * 2048;
        const int L = fq * 16 + fr, rowg0 = u.pm * BM + wr * 64;
        bf16_t* xb = XB + (size_t)(rowg0 + (L >> 3)) * P_D + u.pn * BM + wc * 64 + (L & 7) * 8;
        u32x4 xin[2][4][2];
#pragma unroll
        for (int ai = 0; ai < 2; ++ai)
#pragma unroll
            for (int m = 0; m < 4; ++m) { const bf16_t* p = xb + (size_t)(ai * HALF + m * 16) * P_D; xin[ai][m][0] = *(const u32x4*)p; xin[ai][m][1] = *(const u32x4*)(p + 8 * P_D); }
#pragma unroll
        for (int ai = 0; ai < 2; ++ai)
#pragma unroll
            for (int m = 0; m < 4; ++m) {
                const int row = rowg0 + ai * HALF + m * 16 + fr;
                const float xn = xnorm[row];
                u32x4 x[2]; xpose_in(st, fr, fq, xin[ai][m][0], xin[ai][m][1], x[0], x[1]);
                float sq = 0.f; u32x4 w[2];
#pragma unroll
                for (int bj = 0; bj < 2; ++bj) {
                    const f32x4 v0 = acc[ai][bj][m][0] + (f32x4){bf_lo(x[bj].x), bf_hi(x[bj].x), bf_lo(x[bj].y), bf_hi(x[bj].y)} * xn, v1 = acc[ai][bj][m][1] + (f32x4){bf_lo(x[bj].z), bf_hi(x[bj].z), bf_lo(x[bj].w), bf_hi(x[bj].w)} * xn;
                    w[bj].x = cvt_pk_bf16(v0[0], v0[1]); w[bj].y = cvt_pk_bf16(v0[2], v0[3]); w[bj].z = cvt_pk_bf16(v1[0], v1[1]); w[bj].w = cvt_pk_bf16(v1[2], v1[3]);
                    sq += (v0[0] * v0[0] + v0[1] * v0[1]) + (v0[2] * v0[2] + v0[3] * v0[3]) + (v1[0] * v1[0] + v1[1] * v1[1]) + (v1[2] * v1[2] + v1[3] * v1[3]);
                }
                u32x4 o0, o1; xpose_out(st, fr, fq, w[0], w[1], o0, o1);
                bf16_t* op = xb + (size_t)(ai * HALF + m * 16) * P_D;
                *(u32x4*)op = o0; *(u32x4*)(op + 8 * P_D) = o1;
                sq += __shfl_xor(sq, 16); sq += __shfl_xor(sq, 32);
                if (fq == 0) ssq[(size_t)row * 16 + u.pn * 4 + wc] = sq;
            }
    }
};
typedef EpiRes1T<0> EpiRes1;
template <int VAR = 0> struct EpiFF1T {
    static constexpr bool PERM = true, AFTER_DRAIN = false, HAS_MID = false; static constexpr int MID_T = 0;
    bf16_t* Hd; const float* ssq; PG8_LAS unsigned char* stg;
    __device__ __forceinline__ void operator()(const f32x4 (&acc)[2][2][4][2], const Unit& u, int wr, int wc, int fr, int fq) const {
        PG8_LAS unsigned char* st = stg + (wr * 4 + wc) * 2048;
        const int L = fq * 16 + fr;
        bf16_t* ob = Hd + ((size_t)u.pm * 64 + u.pn * 4 + wc) * 16384 + (size_t)(wr * 64 + (L >> 3)) * 64 + (L & 7) * 8;
#pragma unroll
        for (int ai = 0; ai < 2; ++ai)
#pragma unroll
            for (int m = 0; m < 4; ++m) {
                u32x4 w[2];
#pragma unroll
                for (int bj = 0; bj < 2; ++bj) {
                    f32x4 v0 = acc[ai][bj][m][0], v1 = acc[ai][bj][m][1];
#pragma unroll
                    for (int i = 0; i < 4; ++i) { const float a = fmaxf(v0[i], 0.f), b = fmaxf(v1[i], 0.f); v0[i] = a * a; v1[i] = b * b; }
                    w[bj].x = cvt_pk_bf16(v0[0], v0[1]); w[bj].y = cvt_pk_bf16(v0[2], v0[3]); w[bj].z = cvt_pk_bf16(v1[0], v1[1]); w[bj].w = cvt_pk_bf16(v1[2], v1[3]);
                }
                u32x4 o0, o1; xpose_out(st, fr, fq, w[0], w[1], o0, o1);
                bf16_t* op = ob + (size_t)(ai * HALF + m * 16) * 64;
                *(u32x4*)op = o0; *(u32x4*)(op + 8 * 64) = o1;
            }
    }
};
typedef EpiFF1T<0> EpiFF1;

struct EpiRes2 {
    static constexpr bool PERM = true, AFTER_DRAIN = false, HAS_MID = false; static constexpr int MID_T = 0;
    const bf16_t* X1B; bf16_t* X2B; const float* ssq; PG8_LAS unsigned char* stg;
    __device__ __forceinline__ void operator()(const f32x4 (&acc)[2][2][4][2], const Unit& u, int wr, int wc, int fr, int fq) const {
        const int row0 = u.pm * BM + wr * 64 + fr;
        float rs2[2][4];
#pragma unroll
        for (int ai = 0; ai < 2; ++ai)
#pragma unroll
            for (int m = 0; m < 4; ++m) {
                const f32x4 sq = *((const f32x4*)(ssq + (size_t)(row0 + ai * HALF + m * 16) * 16) + fq);
                float t = (sq[0] + sq[1]) + (sq[2] + sq[3]); t += __shfl_xor(t, 16); t += __shfl_xor(t, 32);
                rs2[ai][m] = t;
            }
        PG8_LAS unsigned char* st = stg + (wr * 4 + wc) * 2048;
        const int L = fq * 16 + fr;
        const size_t roff = (size_t)(u.pm * BM + wr * 64 + (L >> 3)) * P_D + u.pn * BM + wc * 64 + (L & 7) * 8;
        u32x4 xin[2][4][2];
#pragma unroll
        for (int ai = 0; ai < 2; ++ai)
#pragma unroll
            for (int m = 0; m < 4; ++m) { const bf16_t* p = X1B + roff + (size_t)(ai * HALF + m * 16) * P_D; xin[ai][m][0] = *(const u32x4*)p; xin[ai][m][1] = *(const u32x4*)(p + 8 * P_D); }
#pragma unroll
        for (int ai = 0; ai < 2; ++ai)
#pragma unroll
            for (int m = 0; m < 4; ++m) {
                const float r2 = __builtin_amdgcn_rcpf(rs2[ai][m] * (1.f / P_D) + P_EPS);
                u32x4 x[2]; xpose_in(st, fr, fq, xin[ai][m][0], xin[ai][m][1], x[0], x[1]);
                u32x4 w[2];
#pragma unroll
                for (int bj = 0; bj < 2; ++bj) {
                    const f32x4 v0 = acc[ai][bj][m][0] * r2 + (f32x4){bf_lo(x[bj].x), bf_hi(x[bj].x), bf_lo(x[bj].y), bf_hi(x[bj].y)}, v1 = acc[ai][bj][m][1] * r2 + (f32x4){bf_lo(x[bj].z), bf_hi(x[bj].z), bf_lo(x[bj].w), bf_hi(x[bj].w)};
                    w[bj].x = cvt_pk_bf16(v0[0], v0[1]); w[bj].y = cvt_pk_bf16(v0[2], v0[3]); w[bj].z = cvt_pk_bf16(v1[0], v1[1]); w[bj].w = cvt_pk_bf16(v1[2], v1[3]);
                }
                u32x4 o0, o1; xpose_out(st, fr, fq, w[0], w[1], o0, o1);
                bf16_t* op = X2B + roff + (size_t)(ai * HALF + m * 16) * P_D;
                *(u32x4*)op = o0; *(u32x4*)(op + 8 * P_D) = o1;
            }
    }
};

template <class Epi, class Sched, bool ALIGN_EPI = false, bool SP2 = false, bool ATILED = false>
__device__ __forceinline__ void gemm_phase(PG8_LAS unsigned char* lds, const Gemm g, const Sched& S, const Epi& E) {
    const int tid = threadIdx.x, wid = __builtin_amdgcn_readfirstlane(tid >> 6), lane = tid & 63, wr = wid >> 2, wc = wid & 3, fr = lane & 15, fq = lane >> 4;
    const int K = g.K, nt = K / BK;
    unsigned voffA[2], voffB[2];
#pragma unroll
    for (int i = 0; i < 2; ++i) { int R, C; stage_rc(tid * 16 + i * 8192, R, C); const int Rb = Epi::PERM ? sigma0(R) : R;
        voffA[i] = ATILED ? (unsigned)(R * BK + C) * 2u : (unsigned)(R * K + C) * 2u; voffB[i] = (unsigned)(Rb * K + C) * 2u; }
    const size_t kstep = (size_t)(BK * 2);
    const size_t hstep = (size_t)HALF * K * 2;
    const size_t tstep = 2 * hstep;
    const size_t hstepB = Epi::PERM ? (size_t)32 * K * 2 : hstep;
    const size_t kstepA = ATILED ? (size_t)BM * BK * 2 : kstep, hstepA = ATILED ? (size_t)HALF * BK * 2 : hstep;
    const unsigned ldsw = (unsigned)wid * 1024u;
    const int aoff = lds_byte(wr * 64 + fr, fq * 8), boff = lds_byte(wc * 32 + fr, fq * 8);
#define PG8_SA(b, h) (((b) * 2 + (h)) * HTB)
#define PG8_SB(b, h) ((4 + (b) * 2 + (h)) * HTB)
#define PG8_STAGE(bufoff, gbase, voff) do { _Pragma("unroll") for (int _i = 0; _i < 2; ++_i) \
        __builtin_amdgcn_global_load_lds((const unsigned*)((const char*)(gbase) + (voff)[_i]), (PG8_LAS unsigned*)(lds + (bufoff) + ldsw + _i * 8192), 16, 0, 0); } while (0)
#define PG8_LDA(dst, b, h) do { _Pragma("unroll") for (int m = 0; m < 4; ++m) _Pragma("unroll") for (int k = 0; k < 2; ++k) dst[m][k] = *(const PG8_LAS bf16x8*)(lds + PG8_SA(b, h) + aoff + m * 2048 + k * 1024); } while (0)
#define PG8_LDB(dst, b, h) do { _Pragma("unroll") for (int n = 0; n < 2; ++n) _Pragma("unroll") for (int k = 0; k < 2; ++k) dst[n][k] = *(const PG8_LAS bf16x8*)(lds + PG8_SB(b, h) + boff + n * 2048 + k * 1024); } while (0)
#define PG8_MMA(ai, bj, At, Bt) do { __builtin_amdgcn_s_setprio(1); _Pragma("unroll") for (int m = 0; m < 4; ++m) _Pragma("unroll") for (int n = 0; n < 2; ++n) _Pragma("unroll") for (int k = 0; k < 2; ++k) \
        acc[ai][bj][m][n] = __builtin_amdgcn_mfma_f32_16x16x32_bf16(Bt[n][k], At[m][k], acc[ai][bj][m][n], 0, 0, 0); __builtin_amdgcn_s_setprio(0); } while (0)
#define PG8_WAIT_V(n) asm volatile("s_waitcnt vmcnt(" #n ")" ::: "memory")
#define PG8_WAIT_L(n) asm volatile("s_waitcnt lgkmcnt(" #n ")" ::: "memory")
#define PG8_BAR __builtin_amdgcn_s_barrier()
#define PG8_SCHED __builtin_amdgcn_sched_barrier(0)
    Unit cur, nxt; int ui = 0;
    if (!S.next(0, cur)) return;
    f32x4 acc[2][2][4][2];
#pragma unroll
    for (int a = 0; a < 2; ++a)
#pragma unroll
        for (int b = 0; b < 2; ++b)
#pragma unroll
            for (int m = 0; m < 4; ++m)
#pragma unroll
                for (int n = 0; n < 2; ++n) acc[a][b][m][n] = (f32x4){0.f, 0.f, 0.f, 0.f};
    bf16x8 At[4][2], B0[2][2], B1[2][2];
    const char* cA = (const char*)g.A + (size_t)(cur.pm & g.pm_mask) * tstep; const char* cB = (const char*)g.Bt + (size_t)(cur.pn & g.pn_mask) * tstep;
    S.a_ready(cur);
    if constexpr (SP2) {
        PG8_STAGE(PG8_SB(0, 0), cB, voffB); PG8_STAGE(PG8_SB(0, 1), cB + hstepB, voffB); PG8_STAGE(PG8_SA(0, 0), cA, voffA); PG8_STAGE(PG8_SA(0, 1), cA + hstepA, voffA);
        if (wr == 1) PG8_BAR;
        PG8_WAIT_V(2); PG8_BAR;
        PG8_STAGE(PG8_SB(1, 0), cB + kstep, voffB); PG8_STAGE(PG8_SA(1, 0), cA + kstepA, voffA); PG8_STAGE(PG8_SB(1, 1), cB + hstepB + kstep, voffB);
        PG8_WAIT_V(6); PG8_BAR;
    } else {
        PG8_STAGE(PG8_SB(0, 0), cB, voffB); PG8_STAGE(PG8_SA(0, 0), cA, voffA); PG8_STAGE(PG8_SB(0, 1), cB + hstepB, voffB); PG8_STAGE(PG8_SA(0, 1), cA + hstepA, voffA);
        if (wr == 1) PG8_BAR;
        PG8_WAIT_V(4); PG8_BAR;
        PG8_STAGE(PG8_SB(1, 0), cB + kstep, voffB); PG8_STAGE(PG8_SA(1, 0), cA + kstepA, voffA); PG8_STAGE(PG8_SB(1, 1), cB + hstepB + kstep, voffB);
        PG8_WAIT_V(6); PG8_BAR;
    }
    for (;;) {
        const bool has_next = S.next(ui + 1, nxt);
        const char* nA = has_next ? (const char*)g.A + (size_t)(nxt.pm & g.pm_mask) * tstep : cA; const char* nB = has_next ? (const char*)g.Bt + (size_t)(nxt.pn & g.pn_mask) * tstep : cB;
        for (int t = 0; t < nt; t += 2) {
            if constexpr (Epi::HAS_MID) { if (t == Epi::MID_T) E.mid(acc, cur, wr, wc, fr, fq); }
            const bool last = (t == nt - 2);
            const char* a1 = cA + (size_t)(t + 1) * kstepA;
            const char* a2 = last ? nA : cA + (size_t)(t + 2) * kstepA; const char* b2 = last ? nB : cB + (size_t)(t + 2) * kstep;
            const char* a3 = a2 + kstepA; const char* b3 = b2 + kstep;
            if (last && has_next) S.a_ready(nxt);
            if constexpr (SP2) {
            PG8_LDB(B0, 0, 0); PG8_LDB(B1, 0, 1); PG8_SCHED; PG8_LDA(At, 0, 0); PG8_STAGE(PG8_SA(1, 1), a1 + hstepA, voffA);
            PG8_WAIT_V(8); PG8_WAIT_L(0); PG8_BAR; PG8_MMA(0, 0, At, B0); PG8_MMA(0, 1, At, B1); PG8_BAR; PG8_SCHED;
            PG8_LDA(At, 0, 1); PG8_STAGE(PG8_SB(0, 0), b2, voffB); PG8_STAGE(PG8_SB(0, 1), b2 + hstepB, voffB); PG8_STAGE(PG8_SA(0, 0), a2, voffA);
            PG8_WAIT_V(8); PG8_WAIT_L(0); PG8_BAR; PG8_MMA(1, 0, At, B0); PG8_MMA(1, 1, At, B1); PG8_BAR; PG8_SCHED;
            PG8_LDB(B0, 1, 0); PG8_LDB(B1, 1, 1); PG8_SCHED; PG8_LDA(At, 1, 0); PG8_STAGE(PG8_SA(0, 1), a2 + hstepA, voffA);
            PG8_WAIT_V(8); PG8_WAIT_L(0); PG8_BAR; PG8_MMA(0, 0, At, B0); PG8_MMA(0, 1, At, B1); PG8_BAR; PG8_SCHED;
            PG8_LDA(At, 1, 1); PG8_STAGE(PG8_SB(1, 0), b3, voffB); PG8_STAGE(PG8_SB(1, 1), b3 + hstepB, voffB); PG8_STAGE(PG8_SA(1, 0), a3, voffA);
            PG8_WAIT_V(8); PG8_WAIT_L(0); PG8_BAR; PG8_MMA(1, 0, At, B0); PG8_MMA(1, 1, At, B1); PG8_BAR; PG8_SCHED;
            } else {
            PG8_LDB(B0, 0, 0); PG8_SCHED; PG8_LDA(At, 0, 0); PG8_STAGE(PG8_SA(1, 1), a1 + hstepA, voffA);
            PG8_WAIT_L(8); PG8_BAR; PG8_WAIT_L(0); PG8_MMA(0, 0, At, B0); PG8_BAR; PG8_SCHED;
            PG8_LDB(B1, 0, 1); PG8_STAGE(PG8_SB(0, 0), b2, voffB);
            PG8_BAR; PG8_WAIT_L(0); PG8_MMA(0, 1, At, B1); PG8_BAR;
            PG8_LDA(At, 0, 1); PG8_STAGE(PG8_SA(0, 0), a2, voffA);
            PG8_BAR; PG8_WAIT_L(0); PG8_MMA(1, 0, At, B0); PG8_BAR; PG8_SCHED;
            PG8_STAGE(PG8_SB(0, 1), b2 + hstepB, voffB);
            PG8_WAIT_V(6); PG8_BAR; PG8_MMA(1, 1, At, B1); PG8_BAR;
            PG8_LDB(B0, 1, 0); PG8_SCHED; PG8_LDA(At, 1, 0); PG8_STAGE(PG8_SA(0, 1), a2 + hstepA, voffA);
            PG8_WAIT_L(8); PG8_BAR; PG8_WAIT_L(0); PG8_MMA(0, 0, At, B0); PG8_BAR; PG8_SCHED;
            PG8_LDB(B1, 1, 1); PG8_STAGE(PG8_SB(1, 0), b3, voffB);
            PG8_BAR; PG8_WAIT_L(0); PG8_MMA(0, 1, At, B1); PG8_BAR;
            PG8_LDA(At, 1, 1); PG8_STAGE(PG8_SA(1, 0), a3, voffA);
            PG8_BAR; PG8_WAIT_L(0); PG8_MMA(1, 0, At, B0); PG8_BAR; PG8_SCHED;
            PG8_STAGE(PG8_SB(1, 1), b3 + hstepB, voffB);
            PG8_WAIT_V(6); PG8_BAR; PG8_MMA(1, 1, At, B1); PG8_BAR;
            }
        }
        if constexpr (ALIGN_EPI) { if (wr == 0) PG8_BAR; }
        if constexpr (!Epi::AFTER_DRAIN) { E(acc, cur, wr, wc, fr, fq); S.done(cur); }
        if (!has_next) break;
#pragma unroll
        for (int a = 0; a < 2; ++a)
#pragma unroll
            for (int b = 0; b < 2; ++b)
#pragma unroll
                for (int m = 0; m < 4; ++m)
#pragma unroll
                    for (int n = 0; n < 2; ++n) acc[a][b][m][n] = (f32x4){0.f, 0.f, 0.f, 0.f};
        cur = nxt; cA = nA; cB = nB; ++ui;
        if constexpr (ALIGN_EPI) { if (wr == 1) PG8_BAR; }
    }
    PG8_WAIT_V(0);
    if constexpr (!ALIGN_EPI) { if (wr == 0) PG8_BAR; }
    PG8_BAR;
    if constexpr (Epi::AFTER_DRAIN) { E.fused(acc, cur, wr, wc, fr, fq, lds, wid, lane); S.done(cur); }
#undef PG8_SA
#undef PG8_SB
#undef PG8_STAGE
#undef PG8_LDA
#undef PG8_LDB
#undef PG8_MMA
#undef PG8_WAIT_V
#undef PG8_WAIT_L
#undef PG8_BAR
#undef PG8_SCHED
}
}
#define GAS __attribute__((address_space(1)))
#define LAS __attribute__((address_space(3)))
typedef unsigned short bf16;
typedef unsigned v4u __attribute__((ext_vector_type(4)));
typedef float f32x4 __attribute__((ext_vector_type(4)));
typedef short bf16x8 __attribute__((ext_vector_type(8)));
typedef GAS unsigned gu32;
typedef GAS unsigned long long gu64;
#define RLX_AGENT __ATOMIC_RELAXED, __HIP_MEMORY_SCOPE_AGENT
#define LDS_WAIT() asm volatile("s_waitcnt lgkmcnt(0)" ::: "memory")
#define VM_WAIT() asm volatile("s_waitcnt vmcnt(0)" ::: "memory")
__device__ __forceinline__ unsigned long long rt() { return __builtin_amdgcn_s_memrealtime(); }
__device__ __forceinline__ unsigned f2bf(float f) { unsigned u = __builtin_bit_cast(unsigned, f); return (u + 0x7fffu + ((u >> 16) & 1u)) >> 16; }
__device__ __forceinline__ unsigned pk2(float lo, float hi) { return f2bf(lo) | (f2bf(hi) << 16); }

#define XB_TMO      128
#define XB_XCNT(j)  (256  + 64 * (j))
#define XB_XSUB(j)  (1280 + 64 * (j))
#define XB_XGEN(j)  (2304 + 64 * (j))
#define XB_TOP      3328
#define XB_TOPGEN   3392
#define XCD_BAR_WORDS 3456
#define XB_SPIN_CAP (1u << 18)

__device__ __forceinline__ unsigned xb_ld(unsigned* p)              { return __hip_atomic_load(p, __ATOMIC_RELAXED, __HIP_MEMORY_SCOPE_AGENT); }
__device__ __forceinline__ unsigned xb_add(unsigned* p, unsigned v) { return __hip_atomic_fetch_add(p, v, __ATOMIC_RELAXED, __HIP_MEMORY_SCOPE_AGENT); }
__device__ __forceinline__ unsigned xb_xcc_id() { return (unsigned)__builtin_amdgcn_s_getreg((3 << 11) | 20) & 0xFu; }
#define XB_SPIN(cond, bar) do { unsigned _sp = 0; while (cond) { __builtin_amdgcn_s_sleep(1); \
    if ((++_sp & 255u) == 0u) { if (xb_ld(&(bar)[XB_TMO])) break; if (_sp > XB_SPIN_CAP) { atomicAdd(&(bar)[XB_TMO], 1u); break; } } } } while (0)

struct XcdBarrier {
    unsigned* bar; unsigned x;
    volatile LAS unsigned* st;
};

__device__ __forceinline__ XcdBarrier xcd_barrier_post(unsigned* bar, volatile LAS unsigned* st) {
    XcdBarrier b; b.bar = bar; b.x = xb_xcc_id(); b.st = st;
    if (threadIdx.x == 0) (void)xb_add(&bar[XB_XCNT(b.x)], 1u);
    return b;
}
__device__ __forceinline__ void xcd_barrier_complete(unsigned* bar, unsigned x, unsigned& nloc, unsigned& nx) {
    const unsigned G = gridDim.x * gridDim.y * gridDim.z;
    unsigned sum, cnt, mine, sp = 0u;
    for (;;) {
        sum = 0u; cnt = 0u; mine = 0u;
#pragma unroll
        for (unsigned j = 0; j < 16; ++j) { const unsigned c = xb_ld(&bar[XB_XCNT(j)]); sum += c; cnt += (c > 0u) ? 1u : 0u; mine = (j == x) ? c : mine; }
        if (sum == G) break;
        __builtin_amdgcn_s_sleep(1);
        if ((++sp & 255u) == 0u) { if (xb_ld(&bar[XB_TMO])) break; if (sp > XB_SPIN_CAP) { atomicAdd(&bar[XB_TMO], 1u); break; } }
    }
    nloc = mine > 0u ? mine : 1u; nx = cnt > 0u ? cnt : 1u;
}

__device__ __forceinline__ void xcd_barrier(const XcdBarrier& b) {
    asm volatile("s_waitcnt vmcnt(0)" ::: "memory");
    __syncthreads();
    if (threadIdx.x == 0) {
        unsigned* bar = b.bar;
        __builtin_amdgcn_s_waitcnt(0);
        unsigned nloc = b.st[0], nx = b.st[1];
        if (nloc == 0u) { xcd_barrier_complete(bar, b.x, nloc, nx); b.st[0] = nloc; b.st[1] = nx; }
        const unsigned old = xb_add(&bar[XB_XSUB(b.x)], 1u);
        const unsigned gen = old / nloc;
        if (old + 1u == (gen + 1u) * nloc) {
            __builtin_amdgcn_fence(__ATOMIC_RELEASE, "agent");
            asm volatile("s_waitcnt vmcnt(0)" ::: "memory");
            const unsigned og = xb_add(&bar[XB_TOP], 1u);
            const unsigned tg = og / nx;
            if (og + 1u == (tg + 1u) * nx) xb_add(&bar[XB_TOPGEN], 1u);
            else XB_SPIN(xb_ld(&bar[XB_TOPGEN]) == tg, bar);
            __builtin_amdgcn_fence(__ATOMIC_ACQUIRE, "agent");
            xb_add(&bar[XB_XGEN(b.x)], 1u);
            asm volatile("s_waitcnt vmcnt(0)" ::: "memory");
        } else {
            XB_SPIN(xb_ld(&bar[XB_XGEN(b.x)]) == gen, bar);
            __builtin_amdgcn_fence(__ATOMIC_ACQUIRE, "agent");
            asm volatile("s_waitcnt vmcnt(0)" ::: "memory");
        }
    }
    __syncthreads();
}

constexpr int NWAVES = 8;
#ifndef MK_N_LAUNCHES
#define MK_N_LAUNCHES 1
#endif
#ifndef PROBE_DUP
#define PROBE_DUP 0
#endif
#define NREP(k) (1 + ((PROBE_DUP >> (k)) & 1))
#ifndef PROBE_T
#define PROBE_T -1
#endif
#define PROBE_MULT 4
#ifndef PROBE_BLK
#define PROBE_BLK 0
#endif
constexpr int N_LAUNCHES = MK_N_LAUNCHES;
constexpr int PER_PHASE = 9;
constexpr int MP = 65536, MS = 1024, MT = 66560, DM = 1024, PW = 5888, FF = 4096;
constexpr float EPS = 1e-6f, LOG2E = 1.4426950408889634f;
constexpr size_t MiB = 1u << 20;
constexpr size_t WS_CTL = 0, CTL_ZERO_BYTES = 1 * MiB;
constexpr size_t WS_WIN = 2 * MiB, WS_WAC = 14 * MiB, WS_WO = 16 * MiB, WS_W1 = 18 * MiB, WS_W2 = 26 * MiB;
constexpr size_t WS_RSTD0 = 34 * MiB, WS_SSQ1 = 35 * MiB, WS_LSE = 40 * MiB, WS_BIAST = 45 * MiB;
constexpr size_t WS_SQ = 46 * MiB;
constexpr size_t WS_XB = 52 * MiB;
constexpr size_t WS_CBU = 182 * MiB;
constexpr size_t WS_GT = 312 * MiB;
constexpr size_t WS_QKV = 572 * MiB;
constexpr size_t WS_AB = 860 * MiB;
constexpr size_t WS_MB = 958 * MiB;
constexpr size_t WS_HID = 1088 * MiB;
constexpr size_t WS_SOG = 1608 * MiB;
constexpr size_t WS_END = 1612 * MiB;
static_assert(WS_WIN + (size_t)PW * DM * 2 <= WS_WAC && WS_SSQ1 + (size_t)MT * 64 <= WS_LSE && WS_LSE + (size_t)3 * MT * 16 <= WS_BIAST && WS_SQ + (size_t)MS * 2304 * 2 <= WS_XB && WS_XB + (size_t)MT * DM * 2 <= WS_CBU && WS_CBU + (size_t)MT * DM * 2 <= WS_GT
              && WS_GT + (size_t)260 * 4 * 2 * 65536 * 2 <= WS_QKV && WS_QKV + (size_t)3 * MP * 768 * 2 <= WS_AB && WS_AB + (size_t)MT * 768 * 2 <= WS_MB && WS_MB + (size_t)MT * DM * 2 <= WS_HID && WS_HID + (size_t)MT * FF * 2 <= WS_END, "d_ws map");
constexpr int CW_BAR = 4096;
constexpr int RING_OFF = 0, RING_BYTES = 131072;
constexpr int LDSCTL_OFF = 143360, MISC_OFF = LDSCTL_OFF + 320;
constexpr int LDS_BYTES = 163840, EPI_STAGE_OFF = 147456;
static_assert(MISC_OFF + 128 <= LDS_BYTES, "LDS map");

__constant__ unsigned char BUCKETS[3][132] = {
 {0,1,2,3,4,5,6,7,8,9,10,11,12,13,14,15,16,16,16,16,16,16,17,17,17,17,17,17,17,17,18,18,18,18,18,18,18,18,18,18,19,19,19,19,19,19,19,19,19,19,19,19,19,19,20,20,20,20,20,20,20,20,20,20,20,20,20,20,20,20,20,20,20,21,21,21,21,21,21,21,21,21,21,21,21,21,21,21,21,21,21,21,21,21,21,21,21,21,21,22,22,22,22,22,22,22,22,22,22,22,22,22,22,22,22,22,22,22,22,22,22,22,22,22,22,22,22,22,22,0,0,0},
 {0,4,8,12,16,16,17,17,18,18,19,19,19,19,20,20,20,20,20,21,21,21,21,21,21,22,22,22,22,22,22,22,22,22,23,23,23,23,23,23,23,23,23,23,23,23,24,24,24,24,24,24,24,24,24,24,24,24,24,24,24,24,25,25,25,25,25,25,25,25,25,25,25,25,25,25,25,25,25,25,25,25,25,26,26,26,26,26,26,26,26,26,26,26,26,26,26,26,26,26,26,26,26,26,26,26,26,26,26,26,26,26,26,27,27,27,27,27,27,27,27,27,27,27,27,27,27,27,27,0,0,0},
 {0,16,18,19,20,21,21,22,22,23,23,23,24,24,24,24,25,25,25,25,25,26,26,26,26,26,26,26,26,27,27,27,27,27,27,27,27,27,27,28,28,28,28,28,28,28,28,28,28,28,28,28,29,29,29,29,29,29,29,29,29,29,29,29,29,29,29,29,29,29,30,30,30,30,30,30,30,30,30,30,30,30,30,30,30,30,30,30,30,30,30,30,30,30,30,31,31,31,31,31,31,31,31,31,31,31,31,31,31,31,31,31,31,31,31,31,31,31,31,31,31,31,31,31,31,31,31,31,31,0,0,0}};

struct Frame {
    LAS unsigned char* lds;
    volatile LAS unsigned* MISC;
    gu32* ctl;
    int tid, lane, wave;
    int vcu, G;
    const float *xp, *xs, *sconv, *w_in, *w_ao, *w_co, *w_o, *conv_w, *conv_b, *rel_bias, *g_mix, *g_mlp, *w_ff1, *w_ff2, *g_fin;
    float* out;
    bf16 *WIN_T, *WAC_T, *WO_T, *W1_T, *W2_T, *XB, *HID, *AB, *MB, *OG, *QKV, *SQ, *CBU, *GT, *SOG;
    float *RSTD0, *SSQ1, *BIAST, *LSE, *SLSE;
};

__device__ __forceinline__ float wave_sum(float v) {
#pragma unroll
    for (int o = 1; o < 64; o <<= 1) v += __shfl_xor(v, o);
    return v;
}
__device__ __forceinline__ int win_src_col(int n) {
    if (n < 2816) return n;
    const int base = n < 3840 ? 2816 : 3840, q = (n - base) >> 8, p = (n - base) & 255, w = p >> 6, h = (p >> 5) & 1, o = p & 31;
    if (n < 3840) return (h ? 3328 : 2816) + 128 * q + 32 * w + o;
    return (h ? 4864 : 3840) + 256 * (q >> 1) + 64 * w + 32 * (q & 1) + o;
}
__device__ __forceinline__ void p0_transpose_item(const float* W, int N, bf16* WT, int ldT, int koff, const float* kscale, LAS float* scr, int item, int lane, bool perm = false) {
    const int nblk = N / 32, kb = item / nblk, nb = item % nblk, k0 = 64 * kb, n0 = 32 * nb, ns0 = perm ? win_src_col(n0) : n0;
    float wv[32];
#pragma unroll
    for (int i = 0; i < 32; ++i) wv[i] = W[(size_t)(k0 + 2 * i + (lane >> 5)) * N + ns0 + (lane & 31)];
#pragma unroll
    for (int i = 0; i < 32; ++i) { const int kk = 2 * i + (lane >> 5); const float sc = kscale ? kscale[k0 + kk] : 1.f; scr[kk * 33 + (lane & 31)] = wv[i] * sc; }
    LDS_WAIT(); asm volatile("" ::: "memory");
    const int c = lane & 7;
#pragma unroll
    for (int j = 0; j < 4; ++j) { const int n = (lane >> 3) + 8 * j; const LAS float* s = scr + (8 * c) * 33 + n;
        v4u o; o.x = pk2(s[0 * 33], s[1 * 33]); o.y = pk2(s[2 * 33], s[3 * 33]); o.z = pk2(s[4 * 33], s[5 * 33]); o.w = pk2(s[6 * 33], s[7 * 33]);
        *(GAS v4u*)(WT + (size_t)(n0 + n) * ldT + koff + k0 + 8 * c) = o; }
    LDS_WAIT(); asm volatile("" ::: "memory");
}
template <int NR> __device__ __forceinline__ void p0_load(Frame& F, f32x4 (&v)[NR][4], int m0, int mstride) {
#pragma unroll
    for (int r = 0; r < NR; ++r) { int m = m0 + r * mstride; m = m < MT ? m : MT - 1; const GAS f32x4* xr = (const GAS f32x4*)(m < MP ? F.xp + (size_t)m * DM : F.xs + (size_t)(m - MP) * DM) + F.lane;
#pragma unroll
        for (int j = 0; j < 4; ++j) v[r][j] = xr[64 * j]; }
}
template <int NR> __device__ __forceinline__ void p0_proc(Frame& F, const f32x4 (&v)[NR][4], int m0, int mstride) {
#pragma unroll
    for (int r = 0; r < NR; ++r) { const int m = m0 + r * mstride; if (m < MT) { float s = 0.f;
#pragma unroll
        for (int j = 0; j < 4; ++j) s += (v[r][j].x * v[r][j].x + v[r][j].y * v[r][j].y) + (v[r][j].z * v[r][j].z + v[r][j].w * v[r][j].w);
        const float tot = wave_sum(s), nrm = sqrtf(tot * (1.f / DM) + EPS), rs = 1.0f / nrm;
        GAS unsigned long long* o8 = (GAS unsigned long long*)(F.XB + (size_t)m * DM) + F.lane;
#pragma unroll
        for (int j = 0; j < 4; ++j) o8[64 * j] = (unsigned long long)pk2(v[r][j].x * rs, v[r][j].y * rs) | ((unsigned long long)pk2(v[r][j].z * rs, v[r][j].w * rs) << 32);
        if (F.lane == 0) F.RSTD0[m] = nrm; } }
}
__device__ __forceinline__ void p0_rowpass(Frame& F, int gw, int NGW) {
    constexpr int NR = 4; f32x4 va[NR][4], vb[NR][4];
    int m = gw; if (m >= MT) return;
    p0_load<NR>(F, va, m, NGW);
    for (;;) {
        const int m1 = m + NR * NGW; const bool more1 = m1 < MT;
        if (more1) p0_load<NR>(F, vb, m1, NGW);
        p0_proc<NR>(F, va, m, NGW);
        if (!more1) break;
        const int m2 = m1 + NR * NGW; const bool more2 = m2 < MT;
        if (more2) p0_load<NR>(F, va, m2, NGW);
        p0_proc<NR>(F, vb, m1, NGW);
        if (!more2) break;
        m = m2;
    }
}
__device__ __forceinline__ void p0_prologue(Frame& F) {
    LAS float* scr = (LAS float*)(F.lds + RING_OFF + F.wave * 16384);
    const int gw = F.vcu * NWAVES + F.wave, NGW = F.G * NWAVES;
    constexpr int I_IN = (DM / 64) * (PW / 32);
    for (int it = gw; it < I_IN; it += NGW) p0_transpose_item(F.w_in, PW, F.WIN_T, DM, 0, F.g_mix, scr, it, F.lane, true);
    p0_rowpass(F, gw, NGW);
    for (int i = gw * 64 + F.lane; i < 12 * 132; i += NGW * 64) { const int gh = i / 132, j = i % 132, g = gh >> 2; F.BIAST[i] = j <= 128 ? F.rel_bias[(int)BUCKETS[g][j] * 12 + gh] * LOG2E : 0.f; }
}
__device__ __forceinline__ void p1_tail_weights(Frame& F, int wk, int nwk) {
    LAS float* scr = (LAS float*)(F.lds + RING_OFF + F.wave * 16384);
    constexpr int I_AO = (256 / 64) * (DM / 32), I_CO = (512 / 64) * (DM / 32), I_O = (DM / 64) * (DM / 32), I_1 = (DM / 64) * (FF / 32), I_2 = (FF / 64) * (DM / 32);
    constexpr int NITEMS = I_AO + I_CO + I_O + I_1 + I_2;
    for (int it = wk; it < NITEMS; it += nwk) {
        int r = it;
        if (r < I_AO) { p0_transpose_item(F.w_ao, DM, F.WAC_T, 768, 0, nullptr, scr, r, F.lane); continue; } r -= I_AO;
        if (r < I_CO) { p0_transpose_item(F.w_co, DM, F.WAC_T, 768, 256, nullptr, scr, r, F.lane); continue; } r -= I_CO;
        if (r < I_O) { p0_transpose_item(F.w_o, DM, F.WO_T, DM, 0, nullptr, scr, r, F.lane); continue; } r -= I_O;
        if (r < I_1) { p0_transpose_item(F.w_ff1, FF, F.W1_T, DM, 0, F.g_mlp, scr, r, F.lane); continue; } r -= I_1;
        p0_transpose_item(F.w_ff2, DM, F.W2_T, FF, 0, nullptr, scr, r, F.lane);
    }
}

__device__ __forceinline__ void ld_bf4(const bf16* p, float& a, float& b, float& c, float& d) { const uint2 w = *(const uint2*)p; a = __uint_as_float(w.x << 16); b = __uint_as_float(w.x & 0xffff0000u); c = __uint_as_float(w.y << 16); d = __uint_as_float(w.y & 0xffff0000u); }
__device__ __forceinline__ void ld_bf8(const bf16* p, float (&o)[8]) { const v4u w = *(const v4u*)p;
#pragma unroll
    for (int i = 0; i < 4; ++i) { o[2 * i] = __uint_as_float(w[i] << 16); o[2 * i + 1] = __uint_as_float(w[i] & 0xffff0000u); } }
typedef float f32x16 __attribute__((ext_vector_type(16)));
typedef short s16x4 __attribute__((ext_vector_type(4)));
typedef short v4i16_t __attribute__((ext_vector_type(4)));
constexpr int TB_N = 256;
constexpr int P2_TB_OFF = 0, P2_VST_OFF = 16384;
__device__ __forceinline__ s16x4 vtr(const LAS unsigned char* p) { return __builtin_bit_cast(s16x4, __builtin_amdgcn_ds_read_tr16_b64_v4i16((LAS v4i16_t*)p)); }
__device__ __forceinline__ unsigned cvtpk(float lo, float hi) { unsigned r; asm volatile("v_cvt_pk_bf16_f32 %0, %1, %2" : "=v"(r) : "v"(lo), "v"(hi)); return r; }
__device__ __forceinline__ void attn_unit(Frame& F, int w) {
    const int lane = F.lane, r32 = lane & 31, hi = lane >> 5;
    const int qlin = w & 255, h = (w >> 8) & 3, bg = w >> 10, g = bg % 3, b = bg / 3;
    const int sh = 2 * g, nql = 8 - sh, r = qlin >> nql, qb = qlin & ((1 << nql) - 1);
    const bf16* base = F.QKV + ((size_t)((b * 3 + g) * 4 + h) * 8192 + (size_t)r * (8192 >> sh)) * 64;
    constexpr size_t lstride = 64, KOFF = (size_t)MP * 768;
    const LAS float* tbg = (const LAS float*)(F.lds + P2_TB_OFF) + (g * 4 + h) * TB_N + (r32 - 4 * hi);
    LAS unsigned char* vst = F.lds + P2_VST_OFF + F.wave * 8192;
    bf16x8 qf[4], kf[5][4];
    { const bf16* qp = base + (size_t)(32 * qb + r32) * lstride + hi * 8;
#pragma unroll
      for (int d0 = 0; d0 < 4; ++d0) qf[d0] = *(const bf16x8*)(qp + d0 * 16); }
#pragma unroll
    for (int kt = 0; kt < 5; ++kt) {
        const int tix = qb - 4 + kt < 0 ? 0 : qb - 4 + kt;
        const bf16* kp = base + KOFF + (size_t)(32 * tix + r32) * lstride + hi * 8;
#pragma unroll
        for (int d0 = 0; d0 < 4; ++d0) kf[kt][d0] = *(const bf16x8*)(kp + d0 * 16);
    }
    v4u vv[5][4];
#define P2_VLOAD(kt) do { const int tix_ = qb - 4 + (kt) < 0 ? 0 : qb - 4 + (kt); const bf16* vp_ = base + 2 * KOFF + (size_t)(32 * tix_ + (lane >> 2)) * lstride + (lane & 3) * 8; \
        _Pragma("unroll") for (int pc = 0; pc < 4; ++pc) vv[kt][pc] = *(const v4u*)(vp_ + (size_t)((pc & 1) * 16) * lstride + (pc >> 1) * 32); } while (0)
    P2_VLOAD(0); P2_VLOAD(1);
    asm volatile("" ::: "memory");
    f32x16 s[5];
#pragma unroll
    for (int kt = 0; kt < 5; ++kt) {
        const LAS float* tb = tbg + ((qb - 4 + kt < 0) ? 223 : 160 - 32 * kt);
        f32x16 c;
#pragma unroll
        for (int i = 0; i < 16; ++i) c[i] = tb[-(i & 3) - 8 * (i >> 2)];
#pragma unroll
        for (int d0 = 0; d0 < 4; ++d0) c = __builtin_amdgcn_mfma_f32_32x32x16_bf16(kf[kt][d0], qf[d0], c, 0, 0, 0);
        s[kt] = c;
    }
    P2_VLOAD(2); P2_VLOAD(3); P2_VLOAD(4);
    asm volatile("" ::: "memory");
#undef P2_VLOAD
    float mx = -INFINITY;
#pragma unroll
    for (int kt = 0; kt < 5; ++kt)
#pragma unroll
        for (int i = 0; i < 16; ++i) mx = fmaxf(mx, s[kt][i]);
    mx = fmaxf(mx, __shfl_xor(mx, 32));
    float ls = 0.f;
#pragma unroll
    for (int kt = 0; kt < 5; ++kt)
#pragma unroll
        for (int i = 0; i < 16; ++i) { const float p = __builtin_amdgcn_exp2f(s[kt][i] - mx); s[kt][i] = p; ls += p; }
    ls += __shfl_xor(ls, 32);
    f32x16 ot[2];
#pragma unroll
    for (int i = 0; i < 16; ++i) { ot[0][i] = 0.f; ot[1][i] = 0.f; }
    const int ltr = ((lane >> 4) & 1) * 32 + (lane & 3) * 8 + (4 * hi + ((lane & 15) >> 2)) * 64;
#pragma unroll
    for (int kt = 0; kt < 5; ++kt) {
        LAS unsigned char* vb = vst + (kt & 1) * 4096;
#pragma unroll
        for (int pc = 0; pc < 4; ++pc) *(LAS v4u*)(vb + pc * 1024 + lane * 16) = vv[kt][pc];
#pragma unroll
        for (int ks = 0; ks < 2; ++ks) {
            v4u pw; pw.x = cvtpk(s[kt][8 * ks + 0], s[kt][8 * ks + 1]); pw.y = cvtpk(s[kt][8 * ks + 2], s[kt][8 * ks + 3]); pw.z = cvtpk(s[kt][8 * ks + 4], s[kt][8 * ks + 5]); pw.w = cvtpk(s[kt][8 * ks + 6], s[kt][8 * ks + 7]);
            const bf16x8 pf = __builtin_bit_cast(bf16x8, pw);
#pragma unroll
            for (int d0 = 0; d0 < 2; ++d0) {
                const s16x4 lo = vtr(vb + (d0 * 2 + ks) * 1024 + ltr), hh = vtr(vb + (d0 * 2 + ks) * 1024 + ltr + 512);
                const bf16x8 vf = (bf16x8){lo[0], lo[1], lo[2], lo[3], hh[0], hh[1], hh[2], hh[3]};
                ot[d0] = __builtin_amdgcn_mfma_f32_32x32x16_bf16(vf, pf, ot[d0], 0, 0, 0);
            }
        }
    }
    const float inv = 1.f / ls;
    const size_t row = (size_t)b * 8192 + ((size_t)(32 * qb + r32) << sh) + r;
    bf16* op = F.OG + ((size_t)g * MT + row) * 256 + h * 64 + 4 * hi;
#pragma unroll
    for (int d0 = 0; d0 < 2; ++d0)
#pragma unroll
        for (int i = 0; i < 4; ++i)
            *(uint2*)(op + d0 * 32 + 8 * i) = make_uint2(cvtpk(ot[d0][4 * i] * inv, ot[d0][4 * i + 1] * inv), cvtpk(ot[d0][4 * i + 2] * inv, ot[d0][4 * i + 3] * inv));
    if (hi == 0) F.LSE[((size_t)g * MT + row) * 4 + h] = mx + __builtin_amdgcn_logf(ls);
}
__device__ __forceinline__ void samp_unit(Frame& F, const float* const* caches, int su2) {
    const int l = F.lane, h = l >> 4;
    const int half = su2 & 1, su = su2 >> 1, t = su & 7, bg = su >> 3, g = bg % 3, b = bg / 3;
    const int sh = 2 * g, dil = 1 << sh, win = 128 << sh;
    const bf16* sq = F.SQ + (size_t)(b * 8 + t) * 2304 + g * 256 + 4 * l;
    float q0, q1, q2, q3; ld_bf4(sq, q0, q1, q2, q3);
    const LAS float* bias = (const LAS float*)(F.lds + P2_TB_OFF) + (g * 4 + h) * TB_N + 32;
    const float* cache = caches[g] + (size_t)b * win * 512 + 4 * l;
    float mx = -1e30f, ls = 0.f, o0 = 0.f, o1 = 0.f, o2 = 0.f, o3 = 0.f;
    const int jn = (t >> sh) + 1;
    const int jlo = half ? 65 : jn, jhi = half ? 128 : 64;
    f32x4 ka[8], va[8], kb[8], vb[8];
#define SU_LOAD(K_, V_, j0_) do { const float* cb_ = cache; asm volatile("" : "+v"(cb_)); \
        _Pragma("unroll") for (int u = 0; u < 8; ++u) { const int j = (j0_) + u <= jhi ? (j0_) + u : jhi; const float* kp = cb_ + (size_t)(win + t - j * dil) * 512; \
        asm volatile("global_load_dwordx4 %0, %2, off\n\tglobal_load_dwordx4 %1, %2, off offset:1024" : "=&v"(K_[u]), "=&v"(V_[u]) : "v"(kp) : "memory"); } } while (0)
#define SU_WAIT(K_, V_, N) asm volatile("s_waitcnt vmcnt(" #N ")" : "+v"(K_[0]), "+v"(K_[1]), "+v"(K_[2]), "+v"(K_[3]), "+v"(K_[4]), "+v"(K_[5]), "+v"(K_[6]), "+v"(K_[7]), \
        "+v"(V_[0]), "+v"(V_[1]), "+v"(V_[2]), "+v"(V_[3]), "+v"(V_[4]), "+v"(V_[5]), "+v"(V_[6]), "+v"(V_[7]) :: "memory")
#define SU_USE(K_, V_, j0_) do { float sc[8]; \
        _Pragma("unroll") for (int u = 0; u < 8; ++u) { float p = (q0 * K_[u].x + q1 * K_[u].y) + (q2 * K_[u].z + q3 * K_[u].w); \
            p += __shfl_xor(p, 1); p += __shfl_xor(p, 2); p += __shfl_xor(p, 4); p += __shfl_xor(p, 8); sc[u] = ((j0_) + u <= jhi) ? p + bias[(j0_) + u] : -INFINITY; } \
        float mn = mx; _Pragma("unroll") for (int u = 0; u < 8; ++u) mn = fmaxf(mn, sc[u]); \
        const float al = __builtin_amdgcn_exp2f(mx - mn); ls *= al; o0 *= al; o1 *= al; o2 *= al; o3 *= al; \
        _Pragma("unroll") for (int u = 0; u < 8; ++u) { const float e = __builtin_amdgcn_exp2f(sc[u] - mn); ls += e; o0 += e * V_[u].x; o1 += e * V_[u].y; o2 += e * V_[u].z; o3 += e * V_[u].w; } \
        mx = mn; } while (0)
    if (!half) for (int j = 0; j < jn; ++j) {
        const bf16* kp = sq - (size_t)(j * dil) * 2304 + 768;
        float k0, k1, k2, k3, v0, v1, v2, v3; ld_bf4(kp, k0, k1, k2, k3); ld_bf4(kp + 768, v0, v1, v2, v3);
        float p = (q0 * k0 + q1 * k1) + (q2 * k2 + q3 * k3);
        p += __shfl_xor(p, 1); p += __shfl_xor(p, 2); p += __shfl_xor(p, 4); p += __shfl_xor(p, 8);
        const float sc = p + bias[j], mn = fmaxf(mx, sc), al = __builtin_amdgcn_exp2f(mx - mn), e = __builtin_amdgcn_exp2f(sc - mn);
        ls = ls * al + e; o0 = o0 * al + e * v0; o1 = o1 * al + e * v1; o2 = o2 * al + e * v2; o3 = o3 * al + e * v3; mx = mn;
    }
    #pragma unroll 1
    for (int j0 = jlo; j0 <= jhi; j0 += 32) {
        SU_LOAD(ka, va, j0);
        SU_LOAD(kb, vb, j0 + 8); SU_WAIT(ka, va, 16);
        SU_USE(ka, va, j0);
        SU_LOAD(ka, va, j0 + 16); SU_WAIT(kb, vb, 16);
        SU_USE(kb, vb, j0 + 8);
        SU_LOAD(kb, vb, j0 + 24); SU_WAIT(ka, va, 16);
        SU_USE(ka, va, j0 + 16);
        SU_WAIT(kb, vb, 0);
        SU_USE(kb, vb, j0 + 24);
    }
#undef SU_LOAD
#undef SU_USE
#undef SU_WAIT
    const float inv = 1.f / ls;
    const size_t prow = (size_t)(g * 2 + half) * MS + (b * 8 + t);
    *(uint2*)(F.SOG + prow * 256 + 4 * l) = make_uint2(pk2(o0 * inv, o1 * inv), pk2(o2 * inv, o3 * inv));
    if ((l & 15) == 0) F.SLSE[prow * 4 + h] = mx + __builtin_amdgcn_logf(ls);
}
constexpr int PC_TB = 0, PC_K = 12288, PC_V = PC_K + 49152, PC_Q = PC_V + 49152;
static_assert(PC_Q + 32768 <= LDSCTL_OFF, "attention LDS map");
__device__ __forceinline__ void glds16(const void* gsrc, unsigned lds_dst) { unsigned keep;
    asm volatile("s_mov_b32 %0, m0\n\ts_mov_b32 m0, %2\n\ts_nop 0\n\tglobal_load_lds_dwordx4 %1, off\n\ts_mov_b32 m0, %0" : "=&s"(keep) : "v"(gsrc), "s"(lds_dst) : "memory"); }
#define PC_WAIT_BAR() asm volatile("s_waitcnt vmcnt(0) lgkmcnt(0)\n\ts_barrier" ::: "memory")
struct PcUnit { const bf16* base; int qb0, g, h, sh; size_t row0; };
__device__ __forceinline__ PcUnit pc_decode(Frame& F, int grp) {
    PcUnit u; const int w0 = grp * 8, qlin = w0 & 255; u.h = (w0 >> 8) & 3; const int bg = w0 >> 10; u.g = bg % 3; const int b = bg / 3;
    u.sh = 2 * u.g; const int nql = 8 - u.sh, r = qlin >> nql; u.qb0 = qlin & ((1 << nql) - 1);
    u.base = F.QKV + ((size_t)((b * 3 + u.g) * 4 + u.h) * 8192 + (size_t)r * (8192 >> u.sh)) * 64; u.row0 = (size_t)b * 8192 + r; return u;
}
__device__ __forceinline__ void pc_dma_k(Frame& F, const PcUnit& u, unsigned ldsb) {
    constexpr size_t KOFF = (size_t)MP * 768;
    const int rl = F.lane >> 3, cs = F.lane & 7;
#pragma unroll
    for (int i = 0; i < 6; ++i) { const int idx = F.wave * 6 + i, sl = idx >> 2, p = idx & 3; int tix = u.qb0 - 4 + sl; tix = tix < 0 ? 0 : tix; const int row = 8 * p + rl;
        glds16(u.base + KOFF + (size_t)(32 * tix + row) * 64 + ((cs ^ ((row >> 1) & 7)) * 8), (unsigned)__builtin_amdgcn_readfirstlane((int)(ldsb + PC_K + sl * 4096 + p * 1024))); }
#pragma unroll
    for (int p = 0; p < 4; ++p) { const int row = 8 * p + rl;
        glds16(u.base + (size_t)(32 * (u.qb0 + F.wave) + row) * 64 + ((cs ^ ((row >> 1) & 7)) * 8), (unsigned)__builtin_amdgcn_readfirstlane((int)(ldsb + PC_Q + F.wave * 4096 + p * 1024))); }
}
__device__ __forceinline__ void pc_dma_v(Frame& F, const PcUnit& u, unsigned ldsb) {
    constexpr size_t KOFF = (size_t)MP * 768;
#pragma unroll
    for (int i = 0; i < 6; ++i) { const int idx = F.wave * 6 + i, sl = idx >> 2, pc = idx & 3; int tix = u.qb0 - 4 + sl; tix = tix < 0 ? 0 : tix;
        glds16(u.base + 2 * KOFF + (size_t)(32 * tix + (pc & 1) * 16 + (F.lane >> 2)) * 64 + (pc >> 1) * 32 + (F.lane & 3) * 8, (unsigned)__builtin_amdgcn_readfirstlane((int)(ldsb + PC_V + sl * 4096 + pc * 1024))); }
}
__device__ __forceinline__ void pc_store_o(Frame& F, const PcUnit& u, const f32x16 (&ot)[2], float inv, float lse) {
    const int lane = F.lane, r32 = lane & 31, hi = lane >> 5;
    LAS unsigned char* qs = F.lds + PC_Q + F.wave * 4096;
#pragma unroll
    for (int d0 = 0; d0 < 2; ++d0)
#pragma unroll
        for (int i = 0; i < 4; ++i) { typedef unsigned u32x2w __attribute__((ext_vector_type(2)));
            u32x2w w; w.x = cvtpk(ot[d0][4 * i] * inv, ot[d0][4 * i + 1] * inv); w.y = cvtpk(ot[d0][4 * i + 2] * inv, ot[d0][4 * i + 3] * inv);
            *(LAS u32x2w*)(qs + r32 * 128 + (((4 * d0 + i) ^ ((r32 >> 1) & 7)) * 16) + hi * 8) = w; }
    const int qb = u.qb0 + F.wave;
#pragma unroll
    for (int j = 0; j < 4; ++j) { const int row = 8 * j + (lane >> 3), c = (lane & 7) ^ ((row >> 1) & 7);
        const v4u v = *(const LAS v4u*)(qs + j * 1024 + lane * 16);
        const size_t tok = u.row0 + ((size_t)(32 * qb + row) << u.sh);
        *(v4u*)(F.OG + ((size_t)u.g * MT + tok) * 256 + u.h * 64 + c * 8) = v; }
    if (hi == 0) F.LSE[((size_t)u.g * MT + u.row0 + ((size_t)(32 * qb + r32) << u.sh)) * 4 + u.h] = lse;
}
__device__ __forceinline__ void p2_sample(Frame& F, const float* const* caches) {
    for (int rep_ = 0; rep_ < NREP(9); ++rep_) {
        for (int wi = F.vcu; wi < 2 * 128; wi += F.G)
            for (int g = 0; g < 3; ++g) samp_unit(F, caches, ((((wi >> 1) * 3 + g) * 8 + F.wave) << 1) | (wi & 1));
    }
}
__device__ __forceinline__ void p2a_phase(Frame& F, const float* const* caches) {
    LAS float* tbw = (LAS float*)(F.lds + PC_TB);
    for (int i = F.tid; i < 12 * TB_N; i += NWAVES * 64) { const int gh = i / TB_N, j = i % TB_N - 32; tbw[i] = (j >= 0 && j <= 128) ? F.BIAST[gh * 132 + j] : -INFINITY; }
    __syncthreads();
#if PROBE_T >= 10 && PROBE_T <= 12
    volatile LAS unsigned long long* stp = (volatile LAS unsigned long long*)(F.lds + MISC_OFF + 640);
#define P2STAMP(k) do { __syncthreads(); if (blockIdx.x == PROBE_BLK && F.tid == 0) stp[k] = __builtin_amdgcn_s_memrealtime(); __syncthreads(); } while (0)
#else
#define P2STAMP(k) do {} while (0)
#endif
    P2STAMP(10);
    P2STAMP(11);
    const int lane = F.lane, r32 = lane & 31, hi = lane >> 5;
    const unsigned ldsb = (unsigned)(size_t)F.lds;
    const int nun = 3 * MP * 4 / 32 / NWAVES * NREP(10);
    const int kq_off = r32 * 128, kq_sw = (r32 >> 1) & 7;
    const int ltr = ((lane >> 4) & 1) * 32 + (lane & 3) * 8 + (4 * hi + ((lane & 15) >> 2)) * 64;
    const int upw = (nun + F.G - 1) / F.G;
    int grp = F.vcu * upw; const int gend = grp + upw < nun ? grp + upw : nun;
    if (grp >= gend) { p2_sample(F, caches); return; }
    const int per_g = upw / 3 > 0 ? upw / 3 : 1; const bool mix = (upw % 3 == 0) && (F.G * upw == 3072);
#define PC_SLOT2UNIT(sl) ({ const int s_ = (sl) % 3072, w_ = s_ / upw, i_ = s_ % upw, g_ = i_ / per_g < 3 ? i_ / per_g : 2, n_ = (w_ * per_g + (i_ - g_ * per_g)) & 1023; \
        mix ? (((n_ >> 7) * 3 + g_) * 4 + ((n_ >> 5) & 3)) * 32 + (n_ & 31) : s_; })
    PcUnit cur = pc_decode(F, PC_SLOT2UNIT(grp)), prev = cur;
    pc_dma_k(F, cur, ldsb);
    PC_WAIT_BAR();
    f32x16 ot[2]; float inv_p = 0.f, lse_p = 0.f; bool have_prev = false;
    for (;;) {
        bf16x8 qf[4];
        { const LAS unsigned char* qs = F.lds + PC_Q + F.wave * 4096 + kq_off;
#pragma unroll
          for (int d0 = 0; d0 < 4; ++d0) qf[d0] = *(const LAS bf16x8*)(qs + (((2 * d0 + hi) ^ kq_sw) << 4)); }
        asm volatile("s_waitcnt lgkmcnt(0)" ::: "memory");
        pc_dma_v(F, cur, ldsb);
        if (have_prev) pc_store_o(F, prev, ot, inv_p, lse_p);
        const int qb = cur.qb0 + F.wave;
        const LAS float* tbg = (const LAS float*)(F.lds + PC_TB) + (cur.g * 4 + cur.h) * TB_N + (r32 - 4 * hi);
        f32x16 s[5];
#pragma unroll
        for (int kt = 0; kt < 5; ++kt) {
            const LAS unsigned char* ks = F.lds + PC_K + (F.wave + kt) * 4096 + kq_off;
            bf16x8 kf[4];
#pragma unroll
            for (int d0 = 0; d0 < 4; ++d0) kf[d0] = *(const LAS bf16x8*)(ks + (((2 * d0 + hi) ^ kq_sw) << 4));
            const LAS float* tb = tbg + ((qb - 4 + kt < 0) ? 223 : 160 - 32 * kt);
            f32x16 c;
#pragma unroll
            for (int i = 0; i < 16; ++i) c[i] = tb[-(i & 3) - 8 * (i >> 2)];
#pragma unroll
            for (int d0 = 0; d0 < 4; ++d0) c = __builtin_amdgcn_mfma_f32_32x32x16_bf16(kf[d0], qf[d0], c, 0, 0, 0);
            s[kt] = c;
        }
        float mx = -INFINITY;
#pragma unroll
        for (int kt = 0; kt < 5; ++kt)
#pragma unroll
            for (int i = 0; i < 16; ++i) mx = fmaxf(mx, s[kt][i]);
        mx = fmaxf(mx, __shfl_xor(mx, 32));
        float ls = 0.f;
#pragma unroll
        for (int kt = 0; kt < 5; ++kt)
#pragma unroll
            for (int i = 0; i < 16; ++i) { const float p = __builtin_amdgcn_exp2f(s[kt][i] - mx); s[kt][i] = p; ls += p; }
        ls += __shfl_xor(ls, 32);
        PC_WAIT_BAR();
        const int ngrp = grp + 1; const bool has_next = ngrp < gend;
        PcUnit nxt = cur;
        if (has_next) { nxt = pc_decode(F, PC_SLOT2UNIT(ngrp)); pc_dma_k(F, nxt, ldsb); }
#pragma unroll
        for (int i = 0; i < 16; ++i) { ot[0][i] = 0.f; ot[1][i] = 0.f; }
#pragma unroll
        for (int kt = 0; kt < 5; ++kt) {
            const LAS unsigned char* vb = F.lds + PC_V + (F.wave + kt) * 4096;
#pragma unroll
            for (int ks = 0; ks < 2; ++ks) {
                v4u pw; pw.x = cvtpk(s[kt][8 * ks + 0], s[kt][8 * ks + 1]); pw.y = cvtpk(s[kt][8 * ks + 2], s[kt][8 * ks + 3]); pw.z = cvtpk(s[kt][8 * ks + 4], s[kt][8 * ks + 5]); pw.w = cvtpk(s[kt][8 * ks + 6], s[kt][8 * ks + 7]);
                const bf16x8 pf = __builtin_bit_cast(bf16x8, pw);
#pragma unroll
                for (int d0 = 0; d0 < 2; ++d0) {
                    const s16x4 lo = vtr(vb + (d0 * 2 + ks) * 1024 + ltr), hh = vtr(vb + (d0 * 2 + ks) * 1024 + ltr + 512);
                    const bf16x8 vf = (bf16x8){lo[0], lo[1], lo[2], lo[3], hh[0], hh[1], hh[2], hh[3]};
                    ot[d0] = __builtin_amdgcn_mfma_f32_32x32x16_bf16(vf, pf, ot[d0], 0, 0, 0);
                }
            }
        }
        inv_p = 1.f / ls; lse_p = mx + __builtin_amdgcn_logf(ls); prev = cur; have_prev = true;
        PC_WAIT_BAR();
        if (!has_next) break;
        cur = nxt; grp = ngrp;
    }
    pc_store_o(F, prev, ot, inv_p, lse_p);
    asm volatile("s_waitcnt lgkmcnt(0)" ::: "memory");
    P2STAMP(12);
    p2_sample(F, caches);
}
__device__ __forceinline__ void p2b_token(Frame& F, int R) {
    const int l = F.lane, h = l >> 4;
    const bool samp = R >= MP;
    const int b = samp ? (R - MP) >> 3 : R >> 13, t = samp ? (R - MP) & 7 : R & 8191;
    if (!samp) {
        const float l0 = F.LSE[((size_t)0 * MT + R) * 4 + h], l1 = F.LSE[((size_t)1 * MT + R) * 4 + h], l2 = F.LSE[((size_t)2 * MT + R) * 4 + h];
        const float mm = fmaxf(l0, fmaxf(l1, l2));
        float w0 = __builtin_amdgcn_exp2f(l0 - mm), w1 = __builtin_amdgcn_exp2f(l1 - mm), w2 = __builtin_amdgcn_exp2f(l2 - mm);
        const float wi = 1.f / (w0 + w1 + w2); w0 *= wi; w1 *= wi; w2 *= wi;
        float a0, a1, a2, a3, b0, b1, b2, b3, c0, c1, c2, c3;
        ld_bf4(F.OG + ((size_t)0 * MT + R) * 256 + 4 * l, a0, a1, a2, a3); ld_bf4(F.OG + ((size_t)1 * MT + R) * 256 + 4 * l, b0, b1, b2, b3); ld_bf4(F.OG + ((size_t)2 * MT + R) * 256 + 4 * l, c0, c1, c2, c3);
        *(uint2*)(F.AB + (size_t)R * 768 + 4 * l) = make_uint2(pk2(w0 * a0 + w1 * b0 + w2 * c0, w0 * a1 + w1 * b1 + w2 * c1), pk2(w0 * a2 + w1 * b2 + w2 * c2, w0 * a3 + w1 * b3 + w2 * c3));
    } else {
        const int rs = R - MP; float lv[6], mm = -INFINITY;
#pragma unroll
        for (int p = 0; p < 6; ++p) { lv[p] = F.SLSE[((size_t)p * MS + rs) * 4 + h]; mm = fmaxf(mm, lv[p]); }
        float ws = 0.f, o0 = 0.f, o1 = 0.f, o2 = 0.f, o3 = 0.f;
#pragma unroll
        for (int p = 0; p < 6; ++p) { const float w = __builtin_amdgcn_exp2f(lv[p] - mm); float a0, a1, a2, a3; ld_bf4(F.SOG + ((size_t)p * MS + rs) * 256 + 4 * l, a0, a1, a2, a3);
            ws += w; o0 += w * a0; o1 += w * a1; o2 += w * a2; o3 += w * a3; }
        const float wi = 1.f / ws;
        *(uint2*)(F.AB + (size_t)R * 768 + 4 * l) = make_uint2(pk2(o0 * wi, o1 * wi), pk2(o2 * wi, o3 * wi));
    }
    const int c = 8 * l;
    const bf16* pr = F.CBU + (size_t)R * 1024 + c;
    float cb[8], u0[8], u1[8], u2[8];
    ld_bf8(pr, cb); ld_bf8(pr + 512, u0);
    if (t >= 1) ld_bf8(pr - 1024 + 512, u1);
    else if (samp) { const f32x4 a = *(const f32x4*)(F.sconv + (size_t)(b * 2 + 1) * 512 + c), d = *(const f32x4*)(F.sconv + (size_t)(b * 2 + 1) * 512 + c + 4);
        u1[0] = a.x; u1[1] = a.y; u1[2] = a.z; u1[3] = a.w; u1[4] = d.x; u1[5] = d.y; u1[6] = d.z; u1[7] = d.w; }
    else {
#pragma unroll
        for (int i = 0; i < 8; ++i) u1[i] = 0.f; }
    if (t >= 2) ld_bf8(pr - 2048 + 512, u2);
    else if (samp) { const f32x4 a = *(const f32x4*)(F.sconv + (size_t)(b * 2 + t) * 512 + c), d = *(const f32x4*)(F.sconv + (size_t)(b * 2 + t) * 512 + c + 4);
        u2[0] = a.x; u2[1] = a.y; u2[2] = a.z; u2[3] = a.w; u2[4] = d.x; u2[5] = d.y; u2[6] = d.z; u2[7] = d.w; }
    else {
#pragma unroll
        for (int i = 0; i < 8; ++i) u2[i] = 0.f; }
    float z[8];
#pragma unroll
    for (int i = 0; i < 8; ++i) z[i] = cb[i] * (F.conv_b[c + i] + F.conv_w[c + i] * u2[i] + F.conv_w[512 + c + i] * u1[i] + F.conv_w[1024 + c + i] * u0[i]);
    v4u w; w.x = pk2(z[0], z[1]); w.y = pk2(z[2], z[3]); w.z = pk2(z[4], z[5]); w.w = pk2(z[6], z[7]);
    *(v4u*)(F.AB + (size_t)R * 768 + 256 + c) = w;
}
__device__ __forceinline__ void p2b_quad(Frame& F, int R0) {
    const int l = F.lane, h = l >> 4, c = 8 * l;
    float ls[4][3]; uint2 og[4][3]; v4u cbw[4], uw[6];
#pragma unroll
    for (int i = 0; i < 4; ++i)
#pragma unroll
        for (int g = 0; g < 3; ++g) { ls[i][g] = F.LSE[((size_t)g * MT + R0 + i) * 4 + h]; og[i][g] = *(const uint2*)(F.OG + ((size_t)g * MT + R0 + i) * 256 + 4 * l); }
#pragma unroll
    for (int i = 0; i < 4; ++i) cbw[i] = *(const v4u*)(F.CBU + (size_t)(R0 + i) * 1024 + c);
#pragma unroll
    for (int i = 0; i < 6; ++i) uw[i] = *(const v4u*)(F.CBU + (size_t)(R0 - 2 + i) * 1024 + 512 + c);
    float cw0[8], cw1[8], cw2[8], cbi[8];
#pragma unroll
    for (int j = 0; j < 8; ++j) { cbi[j] = F.conv_b[c + j]; cw0[j] = F.conv_w[c + j]; cw1[j] = F.conv_w[512 + c + j]; cw2[j] = F.conv_w[1024 + c + j]; }
#pragma unroll
    for (int i = 0; i < 4; ++i) {
        const float mm = fmaxf(ls[i][0], fmaxf(ls[i][1], ls[i][2]));
        float w0 = __builtin_amdgcn_exp2f(ls[i][0] - mm), w1 = __builtin_amdgcn_exp2f(ls[i][1] - mm), w2 = __builtin_amdgcn_exp2f(ls[i][2] - mm);
        const float wi = 1.f / (w0 + w1 + w2); w0 *= wi; w1 *= wi; w2 *= wi;
#define BLO(x) __uint_as_float((x) << 16)
#define BHI(x) __uint_as_float((x) & 0xffff0000u)
        const float m0 = w0 * BLO(og[i][0].x) + w1 * BLO(og[i][1].x) + w2 * BLO(og[i][2].x), m1 = w0 * BHI(og[i][0].x) + w1 * BHI(og[i][1].x) + w2 * BHI(og[i][2].x);
        const float m2 = w0 * BLO(og[i][0].y) + w1 * BLO(og[i][1].y) + w2 * BLO(og[i][2].y), m3 = w0 * BHI(og[i][0].y) + w1 * BHI(og[i][1].y) + w2 * BHI(og[i][2].y);
        *(uint2*)(F.AB + (size_t)(R0 + i) * 768 + 4 * l) = make_uint2(pk2(m0, m1), pk2(m2, m3));
        float z[8];
#pragma unroll
        for (int j = 0; j < 4; ++j) {
            const unsigned cbx = cbw[i][j], a2 = uw[i][j], a1 = uw[i + 1][j], a0 = uw[i + 2][j];
            z[2 * j]     = BLO(cbx) * (cbi[2 * j] + cw0[2 * j] * BLO(a2) + cw1[2 * j] * BLO(a1) + cw2[2 * j] * BLO(a0));
            z[2 * j + 1] = BHI(cbx) * (cbi[2 * j + 1] + cw0[2 * j + 1] * BHI(a2) + cw1[2 * j + 1] * BHI(a1) + cw2[2 * j + 1] * BHI(a0));
        }
#undef BLO
#undef BHI
        v4u w; w.x = pk2(z[0], z[1]); w.y = pk2(z[2], z[3]); w.z = pk2(z[4], z[5]); w.w = pk2(z[6], z[7]);
        *(v4u*)(F.AB + (size_t)(R0 + i) * 768 + 256 + c) = w;
    }
}
template <int NR> __device__ __forceinline__ void p8_rows(Frame& F, int m0, int mstride) {
    typedef unsigned u32x2v __attribute__((ext_vector_type(2)));
    u32x2v w[NR][4];
#pragma unroll
    for (int r = 0; r < NR; ++r) { const GAS u32x2v* xr = (const GAS u32x2v*)(F.MB + (size_t)(m0 + r * mstride) * DM) + F.lane;
#pragma unroll
        for (int j = 0; j < 4; ++j) w[r][j] = xr[64 * j]; }
    f32x4 g[4];
#pragma unroll
    for (int j = 0; j < 4; ++j) g[j] = *((const f32x4*)F.g_fin + F.lane + 64 * j);
#pragma unroll
    for (int r = 0; r < NR; ++r) { f32x4 v[4]; float s = 0.f;
#pragma unroll
        for (int j = 0; j < 4; ++j) { v[j] = (f32x4){__uint_as_float(w[r][j].x << 16), __uint_as_float(w[r][j].x & 0xffff0000u), __uint_as_float(w[r][j].y << 16), __uint_as_float(w[r][j].y & 0xffff0000u)};
            s += (v[j].x * v[j].x + v[j].y * v[j].y) + (v[j].z * v[j].z + v[j].w * v[j].w); }
        const float rs = 1.0f / sqrtf(wave_sum(s) * (1.f / DM) + EPS);
        GAS f32x4* o = (GAS f32x4*)(F.out + (size_t)(m0 + r * mstride) * DM) + F.lane;
#pragma unroll
        for (int j = 0; j < 4; ++j) o[64 * j] = v[j] * rs * g[j]; }
}

typedef float f32x4v __attribute__((ext_vector_type(4)));
constexpr int SM_ROWSUM_OFF = MISC_OFF + 256;
template <int KW> __device__ __forceinline__ void sm_partial(const bf16* A, int lda, const bf16* Bt, int ldb, int r0, int c0, int k0, int wave, int lane, f32x4v (&acc)[4][4]) {
    const bf16* ap = A + (size_t)(r0 + (lane & 15)) * lda + k0 + wave * KW + 8 * (lane >> 4);
    const bf16* bp = Bt + (size_t)(c0 + (lane & 15)) * ldb + k0 + wave * KW + 8 * (lane >> 4);
#pragma unroll 2
    for (int k = 0; k < KW; k += 32) {
        bf16x8 af[4], bfr[4];
#pragma unroll
        for (int i = 0; i < 4; ++i) { af[i] = *(const bf16x8*)(ap + (size_t)(16 * i) * lda + k); bfr[i] = *(const bf16x8*)(bp + (size_t)(16 * i) * ldb + k); }
#pragma unroll
        for (int i = 0; i < 4; ++i)
#pragma unroll
            for (int j = 0; j < 4; ++j) acc[i][j] = __builtin_amdgcn_mfma_f32_16x16x32_bf16(bfr[j], af[i], acc[i][j], 0, 0, 0);
    }
}
__device__ __forceinline__ void sm_reduce(Frame& F, const f32x4v (&acc)[4][4], f32x4v (&out)[2]) {
    LAS f32x4v* red = (LAS f32x4v*)(F.lds + RING_OFF);
#pragma unroll
    for (int i = 0; i < 4; ++i)
#pragma unroll
        for (int j = 0; j < 4; ++j) red[(F.wave * 16 + i * 4 + j) * 64 + F.lane] = acc[i][j];
    __syncthreads();
#pragma unroll
    for (int q = 0; q < 2; ++q) { f32x4v t = red[F.tid + 512 * q];
#pragma unroll
        for (int w = 1; w < 8; ++w) t += red[w * 1024 + F.tid + 512 * q];
        out[q] = t; }
    __syncthreads();
}
#define SM_ZERO(acc) do { _Pragma("unroll") for (int i_ = 0; i_ < 4; ++i_) _Pragma("unroll") for (int j_ = 0; j_ < 4; ++j_) acc[i_][j_] = (f32x4v){0.f, 0.f, 0.f, 0.f}; } while (0)
#define SM_SLOT(q, row, col) const int s_ = F.tid + 512 * (q), f_ = s_ >> 6, l_ = s_ & 63; const int row = r0 + 16 * (f_ >> 2) + (l_ & 15), col = c0 + 16 * (f_ & 3) + 4 * (l_ >> 4)
__device__ __forceinline__ float sigm(float x) { return __builtin_amdgcn_rcpf(1.f + __builtin_amdgcn_exp2f(-LOG2E * x)); }
__device__ __forceinline__ void sm_gate(Frame& F, int u) {
    const int r0 = (u >> 4) * 64, c0 = (u & 15) * 64;
    const bf16* A = F.AB + (size_t)MP * 768;
    f32x4v acc[4][4], oa[2], ob[2];
    SM_ZERO(acc); sm_partial<32>(A, 768, F.WAC_T, 768, r0, c0, 0, F.wave, F.lane, acc); sm_reduce(F, acc, oa);
    SM_ZERO(acc); sm_partial<64>(A, 768, F.WAC_T, 768, r0, c0, 256, F.wave, F.lane, acc); sm_reduce(F, acc, ob);
#pragma unroll
    for (int q = 0; q < 2; ++q) { SM_SLOT(q, row, col);
        float a0, a1, a2, a3, b0, b1, b2, b3; const int rit = row & 255, cit = col & 255;
        const bf16* gp = F.GT + (size_t)((256 + (row >> 8)) * 4 + (col >> 8)) * 2 * 65536 + (size_t)((((((rit >> 6) & 1) * 4 + (cit >> 6)) * 2 + (rit >> 7)) * 4 + ((rit >> 4) & 3)) * 2 + ((cit >> 5) & 1)) * 512 + (((cit >> 3) & 3) * 16 + (rit & 15)) * 8 + (cit & 7); ld_bf4(gp, a0, a1, a2, a3); ld_bf4(gp + 65536, b0, b1, b2, b3);
        const float m0 = b0 * (a0 * oa[q][0] + ob[q][0]), m1 = b1 * (a1 * oa[q][1] + ob[q][1]), m2 = b2 * (a2 * oa[q][2] + ob[q][2]), m3 = b3 * (a3 * oa[q][3] + ob[q][3]);
        *(uint2*)(F.MB + (size_t)(MP + row) * DM + col) = make_uint2(pk2(m0, m1), pk2(m2, m3)); }
}
__device__ __forceinline__ void sm_oproj(Frame& F, int u) {
    const int r0 = (u >> 4) * 64, c0 = (u & 15) * 64;
    LAS float* rsum = (LAS float*)(F.lds + SM_ROWSUM_OFF);
    if (F.tid < 64) rsum[F.tid] = 0.f;
    f32x4v acc[4][4], o[2];
    SM_ZERO(acc); sm_partial<128>(F.MB + (size_t)MP * DM, DM, F.WO_T, DM, r0, c0, 0, F.wave, F.lane, acc); sm_reduce(F, acc, o);
#pragma unroll
    for (int q = 0; q < 2; ++q) { SM_SLOT(q, row, col);
        bf16* xp = F.XB + (size_t)(MP + row) * DM + col; float x0, x1, x2, x3; ld_bf4(xp, x0, x1, x2, x3); const float xn = F.RSTD0[MP + row];
        const float v0 = x0 * xn + o[q][0], v1 = x1 * xn + o[q][1], v2 = x2 * xn + o[q][2], v3 = x3 * xn + o[q][3];
        *(uint2*)xp = make_uint2(pk2(v0, v1), pk2(v2, v3));
        __hip_atomic_fetch_add(rsum + (row - r0), (v0 * v0 + v1 * v1) + (v2 * v2 + v3 * v3), __ATOMIC_RELAXED, __HIP_MEMORY_SCOPE_WORKGROUP); }
    __syncthreads();
    if (F.tid < 64) F.SSQ1[(size_t)(MP + r0 + F.tid) * 16 + (u & 15)] = rsum[F.tid];
    __syncthreads();
}
__device__ __forceinline__ void sm_down(Frame& F, int u) {
    const int r0 = (u >> 4) * 64, c0 = (u & 15) * 64;
    f32x4v acc[4][4], o[2];
    SM_ZERO(acc);
    {
        const int lane = F.lane, rit = (r0 & 255) + (lane & 15);
        const bf16* ap = F.HID + ((size_t)(256 + (r0 >> 8)) * 64 + F.wave * 8) * 16384 + (size_t)rit * 64 + 8 * (lane >> 4);
        const bf16* bp = F.W2_T + (size_t)(c0 + (lane & 15)) * FF + F.wave * 512 + 8 * (lane >> 4);
#pragma unroll 2
        for (int k = 0; k < 512; k += 32) {
            bf16x8 af[4], bfr[4];
#pragma unroll
            for (int i = 0; i < 4; ++i) { af[i] = *(const bf16x8*)(ap + (size_t)(k >> 6) * 16384 + (size_t)(16 * i) * 64 + (k & 32)); bfr[i] = *(const bf16x8*)(bp + (size_t)(16 * i) * FF + k); }
#pragma unroll
            for (int i = 0; i < 4; ++i)
#pragma unroll
                for (int j = 0; j < 4; ++j) acc[i][j] = __builtin_amdgcn_mfma_f32_16x16x32_bf16(bfr[j], af[i], acc[i][j], 0, 0, 0);
        }
    }
    sm_reduce(F, acc, o);
#pragma unroll
    for (int q = 0; q < 2; ++q) { SM_SLOT(q, row, col);
        float x0, x1, x2, x3; ld_bf4(F.XB + (size_t)(MP + row) * DM + col, x0, x1, x2, x3);
        const f32x4* sp = (const f32x4*)(F.SSQ1 + (size_t)(MP + row) * 16); const f32x4 t0 = sp[0], t1 = sp[1], t2 = sp[2], t3 = sp[3];
        const float rs2 = __builtin_amdgcn_rcpf((((t0[0] + t0[1]) + (t0[2] + t0[3])) + ((t1[0] + t1[1]) + (t1[2] + t1[3])) + ((t2[0] + t2[1]) + (t2[2] + t2[3])) + ((t3[0] + t3[1]) + (t3[2] + t3[3]))) * (1.f / DM) + EPS);
        *(uint2*)(F.MB + (size_t)(MP + row) * DM + col) = make_uint2(pk2(x0 + rs2 * o[q][0], x1 + rs2 * o[q][1]), pk2(x2 + rs2 * o[q][2], x3 + rs2 * o[q][3])); }
}

struct Args { const float* in[18]; float* out; unsigned char* ws; int ph_lo, ph_hi, li, pad; };
__global__ void __launch_bounds__(NWAVES * 64, 2) mk_fwd(Args args) {
    extern __shared__ __attribute__((aligned(16))) unsigned char lds[];
    Frame F;
    F.lds = (LAS unsigned char*)lds;
    F.MISC = (volatile LAS unsigned*)(F.lds + MISC_OFF);
    F.tid = threadIdx.x; F.lane = F.tid & 63; F.wave = __builtin_amdgcn_readfirstlane(F.tid >> 6);
    F.G = gridDim.x; { const int bx = blockIdx.x; F.vcu = (F.G % 8 == 0) ? (bx % 8) * (F.G / 8) + bx / 8 : bx; }
    unsigned char* ws = args.ws;
    F.ctl = (gu32*)(ws + WS_CTL);
    F.xp = args.in[0]; F.xs = args.in[1];  F.sconv = args.in[5];
    F.w_in = args.in[6]; F.w_ao = args.in[7]; F.w_co = args.in[8]; F.w_o = args.in[9]; F.conv_w = args.in[10]; F.conv_b = args.in[11]; F.rel_bias = args.in[12];
    F.g_mix = args.in[13]; F.g_mlp = args.in[14]; F.w_ff1 = args.in[15]; F.w_ff2 = args.in[16]; F.g_fin = args.in[17];
    F.out = args.out;
    F.WIN_T = (bf16*)(ws + WS_WIN); F.WAC_T = (bf16*)(ws + WS_WAC); F.WO_T = (bf16*)(ws + WS_WO); F.W1_T = (bf16*)(ws + WS_W1); F.W2_T = (bf16*)(ws + WS_W2);
    F.XB = (bf16*)(ws + WS_XB); F.HID = (bf16*)(ws + WS_HID); F.AB = (bf16*)(ws + WS_AB); F.MB = (bf16*)(ws + WS_MB); F.OG = (bf16*)(ws + WS_MB); F.QKV = (bf16*)(ws + WS_QKV);
    F.SQ = (bf16*)(ws + WS_SQ); F.SOG = (bf16*)(ws + WS_SOG); F.SLSE = (float*)(ws + WS_SOG + (size_t)6 * MS * 256 * 2); F.CBU = (bf16*)(ws + WS_CBU); F.GT = (bf16*)(ws + WS_GT);
    F.RSTD0 = (float*)(ws + WS_RSTD0); F.SSQ1 = (float*)(ws + WS_SSQ1); F.BIAST = (float*)(ws + WS_BIAST); F.LSE = (float*)(ws + WS_LSE);
    for (int u = F.tid; u < (LDS_BYTES - LDSCTL_OFF) / 4; u += NWAVES * 64) ((LAS unsigned*)(F.lds + LDSCTL_OFF))[u] = 0u;
    __syncthreads();
    XcdBarrier bar; bar.bar = (unsigned*)(F.ctl + CW_BAR); bar.x = 0; bar.st = nullptr;
    if (N_LAUNCHES != PER_PHASE) bar = xcd_barrier_post((unsigned*)(F.ctl + CW_BAR), F.MISC + 8);
#define GRID_BAR() do { if (N_LAUNCHES != PER_PHASE) xcd_barrier(bar); } while (0)
#if PROBE_T >= 0
    volatile LAS unsigned long long* stamps = (volatile LAS unsigned long long*)(F.lds + MISC_OFF + 640);
#define STAMP(k) do { if (blockIdx.x == PROBE_BLK && F.tid == 0) { stamps[k] = __builtin_amdgcn_s_memrealtime(); stamps[16 + (k)] = __builtin_amdgcn_s_memtime(); } } while (0)
#else
#define STAMP(k) do {} while (0)
#endif
    STAMP(0);
    const int lo = args.ph_lo, hi = args.ph_hi;
#define IN(k) (lo <= (k) && (k) < hi)
#define BOTH(k) (IN(k) && IN((k) + 1))
    const int gw = F.vcu * NWAVES + F.wave, NGW = F.G * NWAVES;

    if (IN(0)) { for (int rep_ = 0; rep_ < NREP(0); ++rep_) p0_prologue(F); if (BOTH(0)) GRID_BAR(); STAMP(1); }
    if (IN(1)) {
        pg8::Gemm g{F.XB, F.WIN_T, MT, PW, DM}; pg8::StaticOrder S; S.init(MT, PW, F.G, (int)blockIdx.x, NREP(1));
        pg8::EpiProj E{F.out, F.QKV, F.SQ, F.CBU, F.GT, F.lds + EPI_STAGE_OFF};
        pg8::gemm_phase<pg8::EpiProj, pg8::StaticOrder, true, true>(F.lds + RING_OFF, g, S, E);
        {
            const int ntile = (MT / 256) * (PW / 256), nfull = ntile % F.G;
            if (nfull == 0) p1_tail_weights(F, (int)blockIdx.x * NWAVES + F.wave, F.G * NWAVES);
            else if ((int)blockIdx.x >= nfull) p1_tail_weights(F, ((int)blockIdx.x - nfull) * NWAVES + F.wave, (F.G - nfull) * NWAVES);
        }
        if (BOTH(1)) GRID_BAR(); STAMP(2);
    }
    if (IN(2)) { for (int rep_ = 0; rep_ < NREP(2); ++rep_) p2a_phase(F, &args.in[2]); if (BOTH(2)) GRID_BAR(); STAMP(3); }
    if (IN(3)) { for (int rep_ = 0; rep_ < NREP(3); ++rep_) {
            for (int R0 = 4 * gw; R0 < MP; R0 += 4 * NGW) { if ((R0 & 8191) != 0) p2b_quad(F, R0); else { p2b_token(F, R0); p2b_token(F, R0 + 1); p2b_token(F, R0 + 2); p2b_token(F, R0 + 3); } }
            for (int sidx = gw; sidx < 2 * MS; sidx += NGW) if (!(sidx & 1)) p2b_token(F, MP + (sidx >> 1));
        } if (BOTH(3)) GRID_BAR(); STAMP(4); }
    if (IN(4)) {
        pg8::Gemm g{F.AB, F.WAC_T, MP, DM, 768}; pg8::StaticOrder S; S.init(MP, DM, F.G, (int)blockIdx.x, NREP(4));
        pg8::EpiGate E{F.MB, F.GT, F.lds + EPI_STAGE_OFF};
        pg8::gemm_phase<pg8::EpiGate, pg8::StaticOrder, true, true>(F.lds + RING_OFF, g, S, E);
        for (int u = F.vcu; u < 256; u += F.G) sm_gate(F, u);
        if (BOTH(4)) GRID_BAR(); STAMP(5);
    }
    if (IN(5)) {
        pg8::Gemm g{F.MB, F.WO_T, MP, DM, DM}; pg8::StaticOrder S; S.init(MP, DM, F.G, (int)blockIdx.x, NREP(5));
        pg8::EpiRes1 E{F.XB, F.SSQ1, F.RSTD0, F.lds + EPI_STAGE_OFF};
        pg8::gemm_phase<pg8::EpiRes1, pg8::StaticOrder, true, true>(F.lds + RING_OFF, g, S, E);
        for (int u = F.vcu; u < 256; u += F.G) sm_oproj(F, u);
        if (BOTH(5)) GRID_BAR(); STAMP(6);
    }
    if (IN(6)) {
        pg8::Gemm g{F.XB, F.W1_T, MT, FF, DM}; pg8::StaticOrder S; S.init(MT, FF, F.G, (int)blockIdx.x, NREP(6));
        pg8::EpiFF1 E{F.HID, F.SSQ1, F.lds + EPI_STAGE_OFF};
        pg8::gemm_phase<pg8::EpiFF1, pg8::StaticOrder, true, true>(F.lds + RING_OFF, g, S, E);
        if (BOTH(6)) GRID_BAR(); STAMP(7);
    }
    if (IN(7)) {
        pg8::Gemm g{F.HID, F.W2_T, MP, DM, FF}; pg8::StaticOrder S; S.init(MP, DM, F.G, (int)blockIdx.x, NREP(7));
        pg8::EpiRes2 E{F.XB, F.MB, F.SSQ1, F.lds + EPI_STAGE_OFF};
        pg8::gemm_phase<pg8::EpiRes2, pg8::StaticOrder, true, true, true>(F.lds + RING_OFF, g, S, E);
        for (int u = F.vcu; u < 256; u += F.G) sm_down(F, u);
        if (BOTH(7)) GRID_BAR(); STAMP(8);
    }
#if (PROBE_DUP >> 17) & 31
    {
        GRID_BAR();
        pg8::Gemm g{F.XB, F.WO_T, MP, DM, DM};
        pg8::StaticOrder S; S.init(MP, DM, F.G, (int)blockIdx.x, 4);
#if (PROBE_DUP >> 17) & 1
        pg8::EpiNone E{}; pg8::gemm_phase<pg8::EpiNone, pg8::StaticOrder, true, true>(F.lds + RING_OFF, g, S, E);
#elif (PROBE_DUP >> 18) & 1
#if (PROBE_DUP >> 21) & 1
        { const unsigned long long t0 = __builtin_amdgcn_s_memrealtime(), d = (unsigned long long)((F.vcu & 31) * 80); while (__builtin_amdgcn_s_memrealtime() - t0 < d) __builtin_amdgcn_s_sleep(4); }
#endif
        pg8::EpiNone E{}; pg8::gemm_phase<pg8::EpiNone, pg8::StaticOrder, true, true>(F.lds + RING_OFF, g, S, E);
#elif (PROBE_DUP >> 19) & 1
        pg8::EpiNone E{}; pg8::gemm_phase<pg8::EpiNone, pg8::StaticOrder, true, true>(F.lds + RING_OFF, g, S, E);
#else
        pg8::EpiNone E{}; pg8::gemm_phase<pg8::EpiNone, pg8::StaticOrder, true, true>(F.lds + RING_OFF, g, S, E);
#endif
        GRID_BAR();
    }
#endif
#if ((PROBE_DUP >> 11) & 63) || ((PROBE_DUP >> 22) & 1)
    {
        GRID_BAR();
        pg8::Gemm g{F.XB, F.W1_T, MT, FF, DM}; if ((PROBE_DUP >> 11) & 1) { g.pm_mask = 1; g.pn_mask = 3; }
        pg8::StaticOrder S; S.init(MT, FF, F.G, (int)blockIdx.x);
#if (PROBE_DUP >> 13) & 1
        pg8::EpiNone E{};
        pg8::gemm_phase<pg8::EpiNone, pg8::StaticOrder, true, true>(F.lds + RING_OFF, g, S, E);
#elif (PROBE_DUP >> 14) & 1
        pg8::EpiNone E{};
        pg8::gemm_phase<pg8::EpiNone, pg8::StaticOrder, true, true>(F.lds + RING_OFF, g, S, E);
#elif (PROBE_DUP >> 22) & 1
        pg8::EpiNone E{};
        pg8::gemm_phase<pg8::EpiNone, pg8::StaticOrder, true, true>(F.lds + RING_OFF, g, S, E);
#elif (PROBE_DUP >> 16) & 1
        pg8::EpiNone E{};
        pg8::gemm_phase<pg8::EpiNone, pg8::StaticOrder, true, true>(F.lds + RING_OFF, g, S, E);
#elif (PROBE_DUP >> 15) & 1
        pg8::EpiNone E{};
        pg8::gemm_phase<pg8::EpiNone, pg8::StaticOrder, true, true>(F.lds + RING_OFF, g, S, E);
#else
        pg8::EpiFF1 E{F.HID, F.SSQ1, F.lds + EPI_STAGE_OFF};
        pg8::gemm_phase<pg8::EpiFF1, pg8::StaticOrder, true, true>(F.lds + RING_OFF, g, S, E);
#endif
        GRID_BAR();
    }
#endif
    if (IN(8)) { int m = gw; for (; m + 3 * NGW < MT; m += 4 * NGW) p8_rows<4>(F, m, NGW); for (; m < MT; m += NGW) p8_rows<1>(F, m, NGW); }
#if PROBE_T >= 0
    {
        STAMP(9);
        if (blockIdx.x == PROBE_BLK && F.tid == 0) {
            const int k = PROBE_T % 100;
            const unsigned long long dr = (PROBE_T == 12 ? stamps[3] : stamps[k + 1]) - stamps[k], dc = stamps[16 + k + 1] - stamps[16 + k];
            const unsigned long long spin = PROBE_T >= 100 ? (dc * 100ull / dr) * 20ull : dr * PROBE_MULT;
            const unsigned long long t0 = __builtin_amdgcn_s_memrealtime();
            while (__builtin_amdgcn_s_memrealtime() - t0 < spin) __builtin_amdgcn_s_sleep(16);
        }
    }
#endif
#undef IN
#undef BOTH
}

extern "C" void kernel_launch(void* const* d_in, const int* in_sizes, int n_in, void* d_out, int out_size, void* d_ws, size_t ws_size, hipStream_t stream) {
    static int grid = 0;
    if (grid == 0) {
        if (n_in != 18 || in_sizes[0] != MP * DM || (size_t)out_size != pg8::O_END || ws_size < WS_END) { fprintf(stderr, "kernel_launch: unexpected shapes: n_in %d in0 %d out %d ws %zu (need %zu)\n", n_in, n_in > 0 ? in_sizes[0] : -1, out_size, ws_size, (size_t)WS_END); grid = -1; return; }
        int dev = 0, cus = 0, per_cu = 0;
        if (hipGetDevice(&dev) != hipSuccess || hipDeviceGetAttribute(&cus, hipDeviceAttributeMultiprocessorCount, dev) != hipSuccess) { fprintf(stderr, "kernel_launch: device query failed\n"); grid = -1; return; }
        if (hipFuncSetAttribute((const void*)mk_fwd, hipFuncAttributeMaxDynamicSharedMemorySize, LDS_BYTES) != hipSuccess) { fprintf(stderr, "kernel_launch: hipFuncSetAttribute failed\n"); grid = -1; return; }
        if (hipOccupancyMaxActiveBlocksPerMultiprocessor(&per_cu, (const void*)mk_fwd, NWAVES * 64, LDS_BYTES) != hipSuccess || per_cu < 1) { fprintf(stderr, "kernel_launch: occupancy query reports %d blocks per CU\n", per_cu); }
        (void)hipGetLastError();
        grid = cus;
    }
    if (grid < 0) return;
    if (hipMemsetAsync((char*)d_ws + WS_CTL, 0, CTL_ZERO_BYTES, stream) != hipSuccess) { fprintf(stderr, "kernel_launch: memset failed\n"); return; }
    Args a{};
    for (int i = 0; i < 18; ++i) a.in[i] = (const float*)d_in[i];
    a.out = (float*)d_out; a.ws = (unsigned char*)d_ws;
    for (int li = 0; li < N_LAUNCHES; ++li) {
        a.ph_lo = (N_LAUNCHES == PER_PHASE) ? li : 0; a.ph_hi = (N_LAUNCHES == PER_PHASE) ? li + 1 : PER_PHASE; a.li = li;
        hipLaunchKernelGGL(mk_fwd, dim3(grid), dim3(NWAVES * 64), LDS_BYTES, stream, a);
        const hipError_t le = hipPeekAtLastError();
        if (le != hipSuccess) { fprintf(stderr, "kernel_launch: launch %d failed: %s\n", li, hipGetErrorName(le)); break; }
    }
}
```

```cpp
#include <hip/hip_runtime.h>
#include <cstdio>
#include <cstdint>
namespace pg8 {
#define PG8_LAS __attribute__((address_space(3)))
typedef unsigned short bf16_t;
typedef short bf16x8 __attribute__((ext_vector_type(8)));
typedef float f32x4 __attribute__((ext_vector_type(4)));
typedef unsigned u32x4 __attribute__((ext_vector_type(4)));
constexpr int BM = 256, BK = 64, HALF = 128, HTB = HALF * BK * 2  , STAGE_BYTES = 8 * HTB, NXCD = 8, WGM = 8;

__host__ __device__ __forceinline__ int lds_byte(int r, int c) { const int st = (r >> 4) * 2 + (c >> 5), rr = r & 15, cc = c & 31, ob = rr * 64 + cc * 2; return st * 1024 + (ob ^ (((ob >> 9) & 1) << 5)); }
__host__ __device__ __forceinline__ void stage_rc(int b, int& R, int& C) { const int st = b / 1024, sb = b % 1024, swz = sb ^ (((sb >> 9) & 1) << 5); R = (st >> 1) * 16 + swz / 64; C = (st & 1) * 32 + (swz % 64) / 2; }
__host__ __device__ __forceinline__ int sigma0(int R) { return (R >> 5) * 64 + ((R & 15) >> 2) * 8 + ((R >> 4) & 1) * 4 + (R & 3); }
__host__ __device__ __forceinline__ int perm32(int rho) { const int n = rho >> 4, i = rho & 15; return 8 * (i >> 2) + 4 * n + (i & 3); }

struct Unit { int pm, pn; };
struct Gemm { const bf16_t* A; const bf16_t* Bt; int M, N, K; int pm_mask = -1, pn_mask = -1; };

struct StaticOrder {
    int nM, nN, nwg, G, c, reps;
    __host__ __device__ void init(int M, int N, int G_, int c_, int reps_ = 1) { nM = M / BM; nN = N / BM; nwg = nM * nN; G = G_; c = c_; reps = reps_; }
    __host__ __device__ bool next(int i, Unit& u) const {
        long L = (long)i * G + c; if (L >= (long)nwg * reps) return false; if (L >= nwg) L %= nwg;
        int wgid = (int)L; { const int q = nwg / NXCD, r = nwg % NXCD, xcd = wgid % NXCD, off = wgid / NXCD; wgid = (xcd < r ? xcd * (q + 1) : r * (q + 1) + (xcd - r) * q) + off; }
        const int nig = WGM * nN, gid = wgid / nig, fm = gid * WGM, gsz = (nM - fm) < WGM ? (nM - fm) : WGM;
        u.pm = fm + ((wgid % nig) % gsz); u.pn = (wgid % nig) / gsz; return true;
    }
    __device__ __forceinline__ void a_ready(const Unit&) const {}
    __device__ __forceinline__ void done(const Unit&) const {}
};

__device__ __forceinline__ unsigned cvt_pk_bf16(float lo, float hi) { unsigned r; asm volatile("v_cvt_pk_bf16_f32 %0, %1, %2" : "=v"(r) : "v"(lo), "v"(hi)); return r; }
typedef float f32x2 __attribute__((ext_vector_type(2)));
typedef unsigned u32x4_t __attribute__((ext_vector_type(4)));
__device__ __forceinline__ void xpose_out(PG8_LAS unsigned char* st, int fr, int fq, const u32x4_t& w0, const u32x4_t& w1, u32x4_t& o0, u32x4_t& o1) {
    const int sw = fr & 7, L = fq * 16 + fr, r0 = L >> 3, c = L & 7;
    *(PG8_LAS u32x4_t*)(st + fr * 128 + ((fq ^ sw) << 4)) = w0;
    *(PG8_LAS u32x4_t*)(st + fr * 128 + (((4 + fq) ^ sw) << 4)) = w1;
    o0 = *(const PG8_LAS u32x4_t*)(st + r0 * 128 + ((c ^ (r0 & 7)) << 4));
    o1 = *(const PG8_LAS u32x4_t*)(st + (r0 + 8) * 128 + ((c ^ (r0 & 7)) << 4));
}
__device__ __forceinline__ void xpose_in(PG8_LAS unsigned char* st, int fr, int fq, const u32x4_t& i0, const u32x4_t& i1, u32x4_t& w0, u32x4_t& w1) {
    const int sw = fr & 7, L = fq * 16 + fr, r0 = L >> 3, c = L & 7;
    *(PG8_LAS u32x4_t*)(st + r0 * 128 + ((c ^ (r0 & 7)) << 4)) = i0;
    *(PG8_LAS u32x4_t*)(st + (r0 + 8) * 128 + ((c ^ (r0 & 7)) << 4)) = i1;
    w0 = *(const PG8_LAS u32x4_t*)(st + fr * 128 + ((fq ^ sw) << 4));
    w1 = *(const PG8_LAS u32x4_t*)(st + fr * 128 + (((4 + fq) ^ sw) << 4));
}
typedef unsigned u32x2 __attribute__((ext_vector_type(2)));
constexpr int P_MP = 65536, P_MT = 66560, P_PW = 5888, P_D = 1024, P_FF = 4096;
constexpr float P_EPS = 1e-6f;
constexpr float P_QSCALE = 0.125f * 1.4426950408889634f;
constexpr size_t O_Y = 0, O_KVP0 = 68157440, O_KVP1 = 68681728, O_KVP2 = 70778880, O_CONVP = 79167488, O_KVS0 = 79175680, O_KVS1 = 79699968, O_KVS2 = 80224256, O_CONVS = 80748544, O_END = 80879616;
__device__ __forceinline__ float bf_lo(unsigned w) { return __uint_as_float(w << 16); }
__device__ __forceinline__ float bf_hi(unsigned w) { return __uint_as_float(w & 0xffff0000u); }

struct EpiProj {
    static constexpr bool PERM = true, AFTER_DRAIN = false, HAS_MID = false; static constexpr int MID_T = 0;
    float* out; bf16_t *QKV, *SQ, *CBU, *GT; PG8_LAS unsigned char* stg;
    __device__ __forceinline__ void operator()(const f32x4 (&acc)[2][2][4][2], const Unit& u, int wr, int wc, int fr, int fq) const {
        const int pn = u.pn;
        const int cin = wc * 64 + 8 * fq;
        PG8_LAS unsigned char* st = stg + (wr * 4 + wc) * 2048;
        const int L = fq * 16 + fr, r0 = L >> 3, cc8 = (L & 7) * 8;
        if (pn < 9) {
            const bool prompt = u.pm * BM < P_MP;
            const int cg = pn % 3, csh = 2 * cg;
            const float qs = (pn < 3) ? P_QSCALE : 1.f;
            const bool iskv = pn >= 3;
            const int kv = pn / 3 - 1, win = 128 << csh;
            const size_t okp = cg == 0 ? O_KVP0 : (cg == 1 ? O_KVP1 : O_KVP2), oks = cg == 0 ? O_KVS0 : (cg == 1 ? O_KVS1 : O_KVS2);
            bf16_t* const qkvh = QKV + (size_t)(pn / 3) * ((size_t)P_MP * 768) + cc8;
#pragma unroll
            for (int ai = 0; ai < 2; ++ai)
#pragma unroll
                for (int m = 0; m < 4; ++m) {
                    const int rowg = u.pm * BM + ai * HALF + wr * 64 + m * 16, row = rowg + fr;
                    float* kvp = nullptr;
                    if (iskv) {
                        if (!prompt) kvp = out + oks + ((size_t)(row - P_MP) * 2 + kv) * 256 + cin;
                        else { const int b = row >> 13, t = row & 8191; if (t >= 8192 - win) kvp = out + okp + ((size_t)(b * win + t - (8192 - win)) * 2 + kv) * 256 + cin; }
                    }
                    u32x4 w[2];
#pragma unroll
                    for (int bj = 0; bj < 2; ++bj) {
                        const f32x4 v0 = acc[ai][bj][m][0] * qs, v1 = acc[ai][bj][m][1] * qs;
                        w[bj].x = cvt_pk_bf16(v0[0], v0[1]); w[bj].y = cvt_pk_bf16(v0[2], v0[3]); w[bj].z = cvt_pk_bf16(v1[0], v1[1]); w[bj].w = cvt_pk_bf16(v1[2], v1[3]);
                        if (kvp) { *(f32x4*)(kvp + bj * 32) = v0; *(f32x4*)(kvp + bj * 32 + 4) = v1; }
                    }
                    u32x4 o[2]; xpose_out(st, fr, fq, w[0], w[1], o[0], o[1]);
#pragma unroll
                    for (int j = 0; j < 2; ++j) { const int R = rowg + r0 + 8 * j;
                        bf16_t* dst;
                        if (prompt) { const int b = R >> 13, t = R & 8191, cl = t & ((1 << csh) - 1), l = t >> csh;
                            dst = qkvh + ((size_t)((b * 3 + cg) * 4 + wc) * 8192 + (size_t)cl * (8192 >> csh) + l) * 64; }
                        else dst = SQ + (size_t)(R - P_MP) * 2304 + pn * BM + wc * 64 + cc8;
                        *(u32x4*)dst = o[j]; }
                }
        } else if (pn < 11) {
#pragma unroll
            for (int ai = 0; ai < 2; ++ai)
#pragma unroll
                for (int m = 0; m < 4; ++m) {
                    const int rowg = u.pm * BM + ai * HALF + wr * 64 + m * 16;
                    u32x4 w[2];
#pragma unroll
                    for (int bj = 0; bj < 2; ++bj) {
                        const f32x4 v0 = acc[ai][bj][m][0], v1 = acc[ai][bj][m][1];
                        w[bj].x = cvt_pk_bf16(v0[0], v0[1]); w[bj].y = cvt_pk_bf16(v0[2], v0[3]); w[bj].z = cvt_pk_bf16(v1[0], v1[1]); w[bj].w = cvt_pk_bf16(v1[2], v1[3]);
                    }
                    u32x4 o0, o1; xpose_out(st, fr, fq, w[0], w[1], o0, o1);
                    bf16_t* dst = CBU + (size_t)(rowg + r0) * 1024 + (pn - 9) * BM + wc * 64 + cc8;
                    *(u32x4*)dst = o0; *(u32x4*)(dst + 8 * 1024) = o1;
                }
        } else if (pn < 15) {
            const int uc = (pn - 11) * HALF + wc * 32 + 8 * fq;
#pragma unroll
            for (int ai = 0; ai < 2; ++ai)
#pragma unroll
                for (int m = 0; m < 4; ++m) {
                    const int row = u.pm * BM + ai * HALF + wr * 64 + m * 16 + fr;
                    const f32x4 v0 = acc[ai][0][m][0] * acc[ai][1][m][0], v1 = acc[ai][0][m][1] * acc[ai][1][m][1];
                    u32x4 w; w.x = cvt_pk_bf16(v0[0], v0[1]); w.y = cvt_pk_bf16(v0[2], v0[3]); w.z = cvt_pk_bf16(v1[0], v1[1]); w.w = cvt_pk_bf16(v1[2], v1[3]);
                    *(u32x4*)(CBU + (size_t)row * 1024 + 512 + uc) = w;
                    float* cs = nullptr;
                    if (row >= P_MP) { const int rr = row - P_MP, t = rr & 7; if (t >= 6) cs = out + O_CONVS + (size_t)((rr >> 3) * 2 + (t - 6)) * 512 + uc; }
                    else { const int t = row & 8191; if (t >= 8190) cs = out + O_CONVP + (size_t)((row >> 13) * 2 + (t - 8190)) * 512 + uc; }
                    if (cs) { *(f32x4*)cs = v0; *(f32x4*)(cs + 4) = v1; }
                }
        } else {
            const int q = pn - 15;
            bf16_t* gt = GT + (size_t)(u.pm * 4 + (q >> 1)) * 2 * 65536 + (size_t)((wr * 4 + wc) * 16 + (q & 1)) * 512 + (fq * 16 + fr) * 8;
#pragma unroll
            for (int ai = 0; ai < 2; ++ai)
#pragma unroll
                for (int m = 0; m < 4; ++m) {
                    const int rit = ai * HALF + wr * 64 + m * 16 + fr;
                    const float rs = -1.4426950408889634f;
                    float r[8], sg[8];
#pragma unroll
                    for (int n = 0; n < 2; ++n)
#pragma unroll
                        for (int i = 0; i < 4; ++i) {
                            const float ea = 1.f + __builtin_amdgcn_exp2f(acc[ai][0][m][n][i] * rs), eb = 1.f + __builtin_amdgcn_exp2f(acc[ai][1][m][n][i] * rs);
                            sg[4 * n + i] = __builtin_amdgcn_rcpf(eb); r[4 * n + i] = eb * __builtin_amdgcn_rcpf(ea);
                        }
                    u32x4 w; w.x = cvt_pk_bf16(r[0], r[1]); w.y = cvt_pk_bf16(r[2], r[3]); w.z = cvt_pk_bf16(r[4], r[5]); w.w = cvt_pk_bf16(r[6], r[7]);
                    *(u32x4*)(gt + (ai * 4 + m) * 1024) = w;
                    w.x = cvt_pk_bf16(sg[0], sg[1]); w.y = cvt_pk_bf16(sg[2], sg[3]); w.z = cvt_pk_bf16(sg[4], sg[5]); w.w = cvt_pk_bf16(sg[6], sg[7]);
                    *(u32x4*)(gt + 65536 + (ai * 4 + m) * 1024) = w;
                }
        }
    }
};

struct EpiGate {
    static constexpr bool PERM = true, AFTER_DRAIN = false, HAS_MID = true; static constexpr int MID_T = 4;
    bf16_t* Mo; const bf16_t* GT; PG8_LAS unsigned char* stg;
    __device__ __forceinline__ void mid(f32x4 (&acc)[2][2][4][2], const Unit& u, int wr, int wc, int fr, int fq) const {
        int lo = (fq * 16 + fr) * 8;
        asm volatile("" : "+v"(lo));
        const bf16_t* gp = GT + (size_t)(u.pm * 4 + u.pn) * 2 * 65536 + (size_t)(wr * 4 + wc) * 16 * 512 + lo;
        u32x4 rw[2][4][2];
#pragma unroll
        for (int ai = 0; ai < 2; ++ai)
#pragma unroll
            for (int m = 0; m < 4; ++m)
#pragma unroll
                for (int bj = 0; bj < 2; ++bj) rw[ai][m][bj] = *(const u32x4*)(gp + ((ai * 4 + m) * 2 + bj) * 512);
#pragma unroll
        for (int ai = 0; ai < 2; ++ai)
#pragma unroll
            for (int m = 0; m < 4; ++m)
#pragma unroll
                for (int bj = 0; bj < 2; ++bj) { const u32x4 a = rw[ai][m][bj];
                    acc[ai][bj][m][0] = acc[ai][bj][m][0] * (f32x4){bf_lo(a.x), bf_hi(a.x), bf_lo(a.y), bf_hi(a.y)};
                    acc[ai][bj][m][1] = acc[ai][bj][m][1] * (f32x4){bf_lo(a.z), bf_hi(a.z), bf_lo(a.w), bf_hi(a.w)}; }
    }
    __device__ __forceinline__ void operator()(const f32x4 (&acc)[2][2][4][2], const Unit& u, int wr, int wc, int fr, int fq) const {
        const bf16_t* gp = GT + ((size_t)(u.pm * 4 + u.pn) * 2 + 1) * 65536 + (size_t)(wr * 4 + wc) * 16 * 512 + (fq * 16 + fr) * 8;
        u32x4 sw[2][4][2];
#pragma unroll
        for (int ai = 0; ai < 2; ++ai)
#pragma unroll
            for (int m = 0; m < 4; ++m)
#pragma unroll
                for (int bj = 0; bj < 2; ++bj) sw[ai][m][bj] = *(const u32x4*)(gp + ((ai * 4 + m) * 2 + bj) * 512);
        PG8_LAS unsigned char* st = stg + (wr * 4 + wc) * 2048;
        const int L = fq * 16 + fr;
        bf16_t* ob = Mo + (size_t)(u.pm * BM + wr * 64 + (L >> 3)) * P_D + u.pn * BM + wc * 64 + (L & 7) * 8;
#pragma unroll
        for (int ai = 0; ai < 2; ++ai)
#pragma unroll
            for (int m = 0; m < 4; ++m) {
                u32x4 w[2];
#pragma unroll
                for (int bj = 0; bj < 2; ++bj) {
                    const u32x4 a = sw[ai][m][bj];
                    const f32x4 v0 = acc[ai][bj][m][0] * (f32x4){bf_lo(a.x), bf_hi(a.x), bf_lo(a.y), bf_hi(a.y)}, v1 = acc[ai][bj][m][1] * (f32x4){bf_lo(a.z), bf_hi(a.z), bf_lo(a.w), bf_hi(a.w)};
                    w[bj].x = cvt_pk_bf16(v0[0], v0[1]); w[bj].y = cvt_pk_bf16(v0[2], v0[3]); w[bj].z = cvt_pk_bf16(v1[0], v1[1]); w[bj].w = cvt_pk_bf16(v1[2], v1[3]);
                }
                u32x4 o0, o1; xpose_out(st, fr, fq, w[0], w[1], o0, o1);
                bf16_t* op = ob + (size_t)(ai * HALF + m * 16) * P_D;
                *(u32x4*)op = o0; *(u32x4*)(op + 8 * P_D) = o1;
            }
    }
};

struct EpiNone {
    static constexpr bool PERM = true, AFTER_DRAIN = false, HAS_MID = false; static constexpr int MID_T = 0;
    __device__ __forceinline__ void operator()(const f32x4 (&acc)[2][2][4][2], const Unit& u, int wr, int wc, int fr, int fq) const {
#pragma unroll
        for (int ai = 0; ai < 2; ++ai)
#pragma unroll
            for (int bj = 0; bj < 2; ++bj)
#pragma unroll
                for (int m = 0; m < 4; ++m)
#pragma unroll
                    for (int n = 0; n < 2; ++n) asm volatile("" :: "v"(acc[ai][bj][m][n]));
    }
};
template <int VAR = 0> struct EpiRes1T {
    static constexpr bool PERM = true, AFTER_DRAIN = false, HAS_MID = false; static constexpr int MID_T = 0;
    bf16_t* XB; float* ssq; const float* xnorm; PG8_LAS unsigned char* stg;
    __device__ __forceinline__ void operator()(const f32x4 (&acc)[2][2][4][2], const Unit& u, int wr, int wc, int fr, int fq) const {
        PG8_LAS unsigned char* st = stg + (wr * 4 + wc) * 2048;
        const int L = fq * 16 + fr, rowg0 = u.pm * BM + wr * 64;
        bf16_t* xb = XB + (size_t)(rowg0 + (L >> 3)) * P_D + u.pn * BM + wc * 64 + (L & 7) * 8;
        u32x4 xin[2][4][2];
#pragma unroll
        for (int ai = 0; ai < 2; ++ai)
#pragma unroll
            for (int m = 0; m < 4; ++m) { const bf16_t* p = xb + (size_t)(ai * HALF + m * 16) * P_D; xin[ai][m][0] = *(const u32x4*)p; xin[ai][m][1] = *(const u32x4*)(p + 8 * P_D); }
#pragma unroll
        for (int ai = 0; ai < 2; ++ai)
#pragma unroll
            for (int m = 0; m < 4; ++m) {
                const int row = rowg0 + ai * HALF + m * 16 + fr;
                const float xn = xnorm[row];
                u32x4 x[2]; xpose_in(st, fr, fq, xin[ai][m][0], xin[ai][m][1], x[0], x[1]);
                float sq = 0.f; u32x4 w[2];
#pragma unroll
                for (int bj = 0; bj < 2; ++bj) {
                    const f32x4 v0 = acc[ai][bj][m][0] + (f32x4){bf_lo(x[bj].x), bf_hi(x[bj].x), bf_lo(x[bj].y), bf_hi(x[bj].y)} * xn, v1 = acc[ai][bj][m][1] + (f32x4){bf_lo(x[bj].z), bf_hi(x[bj].z), bf_lo(x[bj].w), bf_hi(x[bj].w)} * xn;
                    w[bj].x = cvt_pk_bf16(v0[0], v0[1]); w[bj].y = cvt_pk_bf16(v0[2], v0[3]); w[bj].z = cvt_pk_bf16(v1[0], v1[1]); w[bj].w = cvt_pk_bf16(v1[2], v1[3]);
                    sq += (v0[0] * v0[0] + v0[1] * v0[1]) + (v0[2] * v0[2] + v0[3] * v0[3]) + (v1[0] * v1[0] + v1[1] * v1[1]) + (v1[2] * v1[2] + v1[3] * v1[3]);
                }
                u32x4 o0, o1; xpose_out(st, fr, fq, w[0], w[1], o0, o1);
                bf16_t* op = xb + (size_t)(ai * HALF + m * 16) * P_D;
                *(u32x4*)op = o0; *(u32x4*)(op + 8 * P_D) = o1;
                sq += __shfl_xor(sq, 16); sq += __shfl_xor(sq, 32);
                if (fq == 0) ssq[(size_t)row * 16 + u.pn * 4 + wc] = sq;
            }
    }
};
typedef EpiRes1T<0> EpiRes1;
template <int VAR = 0> struct EpiFF1T {
    static constexpr bool PERM = true, AFTER_DRAIN = false, HAS_MID = false; static constexpr int MID_T = 0;
    bf16_t* Hd; const float* ssq; PG8_LAS unsigned char* stg;
    __device__ __forceinline__ void operator()(const f32x4 (&acc)[2][2][4][2], const Unit& u, int wr, int wc, int fr, int fq) const {
        PG8_LAS unsigned char* st = stg + (wr * 4 + wc) * 2048;
        const int L = fq * 16 + fr;
        bf16_t* ob = Hd + ((size_t)u.pm * 64 + u.pn * 4 + wc) * 16384 + (size_t)(wr * 64 + (L >> 3)) * 64 + (L & 7) * 8;
#pragma unroll
        for (int ai = 0; ai < 2; ++ai)
#pragma unroll
            for (int m = 0; m < 4; ++m) {
                u32x4 w[2];
#pragma unroll
                for (int bj = 0; bj < 2; ++bj) {
                    f32x4 v0 = acc[ai][bj][m][0], v1 = acc[ai][bj][m][1];
#pragma unroll
                    for (int i = 0; i < 4; ++i) { const float a = fmaxf(v0[i], 0.f), b = fmaxf(v1[i], 0.f); v0[i] = a * a; v1[i] = b * b; }
                    w[bj].x = cvt_pk_bf16(v0[0], v0[1]); w[bj].y = cvt_pk_bf16(v0[2], v0[3]); w[bj].z = cvt_pk_bf16(v1[0], v1[1]); w[bj].w = cvt_pk_bf16(v1[2], v1[3]);
                }
                u32x4 o0, o1; xpose_out(st, fr, fq, w[0], w[1], o0, o1);
                bf16_t* op = ob + (size_t)(ai * HALF + m * 16) * 64;
                *(u32x4*)op = o0; *(u32x4*)(op + 8 * 64) = o1;
            }
    }
};
typedef EpiFF1T<0> EpiFF1;

struct EpiRes2 {
    static constexpr bool PERM = true, AFTER_DRAIN = false, HAS_MID = false; static constexpr int MID_T = 0;
    const bf16_t* X1B; bf16_t* X2B; const float* ssq; PG8_LAS unsigned char* stg;
    __device__ __forceinline__ void operator()(const f32x4 (&acc)[2][2][4][2], const Unit& u, int wr, int wc, int fr, int fq) const {
        const int row0 = u.pm * BM + wr * 64 + fr;
        float rs2[2][4];
#pragma unroll
        for (int ai = 0; ai < 2; ++ai)
#pragma unroll
            for (int m = 0; m < 4; ++m) {
                const f32x4 sq = *((const f32x4*)(ssq + (size_t)(row0 + ai * HALF + m * 16) * 16) + fq);
                float t = (sq[0] + sq[1]) + (sq[2] + sq[3]); t += __shfl_xor(t, 16); t += __shfl_xor(t, 32);
                rs2[ai][m] = t;
            }
        PG8_LAS unsigned char* st = stg + (wr * 4 + wc) * 2048;
        const int L = fq * 16 + fr;
        const size_t roff = (size_t)(u.pm * BM + wr * 64 + (L >> 3)) * P_D + u.pn * BM + wc * 64 + (L & 7) * 8;
        u32x4 xin[2][4][2];
#pragma unroll
        for (int ai = 0; ai < 2; ++ai)
#pragma unroll
            for (int m = 0; m < 4; ++m) { const bf16_t* p = X1B + roff + (size_t)(ai * HALF + m * 16) * P_D; xin[ai][m][0] = *(const u32x4*)p; xin[ai][m][1] = *(const u32x4*)(p + 8 * P_D); }
#pragma unroll
        for (int ai = 0; ai < 2; ++ai)
#pragma unroll
            for (int m = 0; m < 4; ++m) {
                const float r2 = __builtin_amdgcn_rcpf(rs2[ai][m] * (1.f / P_D) + P_EPS);
                u32x4 x[2]; xpose_in(st, fr, fq, xin[ai][m][0], xin[ai][m][1], x[0], x[1]);
                u32x4 w[2];
#pragma unroll
                for (int bj = 0; bj < 2; ++bj) {
                    const f32x4 v0 = acc[ai][bj][m][0] * r2 + (f32x4){bf_lo(x[bj].x), bf_hi(x[bj].x), bf_lo(x[bj].y), bf_hi(x[bj].y)}, v1 = acc[ai][bj][m][1] * r2 + (f32x4){bf_lo(x[bj].z), bf_hi(x[bj].z), bf_lo(x[bj].w), bf_hi(x[bj].w)};
                    w[bj].x = cvt_pk_bf16(v0[0], v0[1]); w[bj].y = cvt_pk_bf16(v0[2], v0[3]); w[bj].z = cvt_pk_bf16(v1[0], v1[1]); w[bj].w = cvt_pk_bf16(v1[2], v1[3]);
                }
                u32x4 o0, o1; xpose_out(st, fr, fq, w[0], w[1], o0, o1);
                bf16_t* op = X2B + roff + (size_t)(ai * HALF + m * 16) * P_D;
                *(u32x4*)op = o0; *(u32x4*)(op + 8 * P_D) = o1;
            }
    }
};

template <class Epi, class Sched, bool ALIGN_EPI = false, bool SP2 = false, bool ATILED = false>
__device__ __forceinline__ void gemm_phase(PG8_LAS unsigned char* lds, const Gemm g, const Sched& S, const Epi& E) {
    const int tid = threadIdx.x, wid = __builtin_amdgcn_readfirstlane(tid >> 6), lane = tid & 63, wr = wid >> 2, wc = wid & 3, fr = lane & 15, fq = lane >> 4;
    const int K = g.K, nt = K / BK;
    unsigned voffA[2], voffB[2];
#pragma unroll
    for (int i = 0; i < 2; ++i) { int R, C; stage_rc(tid * 16 + i * 8192, R, C); const int Rb = Epi::PERM ? sigma0(R) : R;
        voffA[i] = ATILED ? (unsigned)(R * BK + C) * 2u : (unsigned)(R * K + C) * 2u; voffB[i] = (unsigned)(Rb * K + C) * 2u; }
    const size_t kstep = (size_t)(BK * 2);
    const size_t hstep = (size_t)HALF * K * 2;
    const size_t tstep = 2 * hstep;
    const size_t hstepB = Epi::PERM ? (size_t)32 * K * 2 : hstep;
    const size_t kstepA = ATILED ? (size_t)BM * BK * 2 : kstep, hstepA = ATILED ? (size_t)HALF * BK * 2 : hstep;
    const unsigned ldsw = (unsigned)wid * 1024u;
    const int aoff = lds_byte(wr * 64 + fr, fq * 8), boff = lds_byte(wc * 32 + fr, fq * 8);
#define PG8_SA(b, h) (((b) * 2 + (h)) * HTB)
#define PG8_SB(b, h) ((4 + (b) * 2 + (h)) * HTB)
#define PG8_STAGE(bufoff, gbase, voff) do { _Pragma("unroll") for (int _i = 0; _i < 2; ++_i) \
        __builtin_amdgcn_global_load_lds((const unsigned*)((const char*)(gbase) + (voff)[_i]), (PG8_LAS unsigned*)(lds + (bufoff) + ldsw + _i * 8192), 16, 0, 0); } while (0)
#define PG8_LDA(dst, b, h) do { _Pragma("unroll") for (int m = 0; m < 4; ++m) _Pragma("unroll") for (int k = 0; k < 2; ++k) dst[m][k] = *(const PG8_LAS bf16x8*)(lds + PG8_SA(b, h) + aoff + m * 2048 + k * 1024); } while (0)
#define PG8_LDB(dst, b, h) do { _Pragma("unroll") for (int n = 0; n < 2; ++n) _Pragma("unroll") for (int k = 0; k < 2; ++k) dst[n][k] = *(const PG8_LAS bf16x8*)(lds + PG8_SB(b, h) + boff + n * 2048 + k * 1024); } while (0)
#define PG8_MMA(ai, bj, At, Bt) do { __builtin_amdgcn_s_setprio(1); _Pragma("unroll") for (int m = 0; m < 4; ++m) _Pragma("unroll") for (int n = 0; n < 2; ++n) _Pragma("unroll") for (int k = 0; k < 2; ++k) \
        acc[ai][bj][m][n] = __builtin_amdgcn_mfma_f32_16x16x32_bf16(Bt[n][k], At[m][k], acc[ai][bj][m][n], 0, 0, 0); __builtin_amdgcn_s_setprio(0); } while (0)
#define PG8_WAIT_V(n) asm volatile("s_waitcnt vmcnt(" #n ")" ::: "memory")
#define PG8_WAIT_L(n) asm volatile("s_waitcnt lgkmcnt(" #n ")" ::: "memory")
#define PG8_BAR __builtin_amdgcn_s_barrier()
#define PG8_SCHED __builtin_amdgcn_sched_barrier(0)
    Unit cur, nxt; int ui = 0;
    if (!S.next(0, cur)) return;
    f32x4 acc[2][2][4][2];
#pragma unroll
    for (int a = 0; a < 2; ++a)
#pragma unroll
        for (int b = 0; b < 2; ++b)
#pragma unroll
            for (int m = 0; m < 4; ++m)
#pragma unroll
                for (int n = 0; n < 2; ++n) acc[a][b][m][n] = (f32x4){0.f, 0.f, 0.f, 0.f};
    bf16x8 At[4][2], B0[2][2], B1[2][2];
    const char* cA = (const char*)g.A + (size_t)(cur.pm & g.pm_mask) * tstep; const char* cB = (const char*)g.Bt + (size_t)(cur.pn & g.pn_mask) * tstep;
    S.a_ready(cur);
    if constexpr (SP2) {
        PG8_STAGE(PG8_SB(0, 0), cB, voffB); PG8_STAGE(PG8_SB(0, 1), cB + hstepB, voffB); PG8_STAGE(PG8_SA(0, 0), cA, voffA); PG8_STAGE(PG8_SA(0, 1), cA + hstepA, voffA);
        if (wr == 1) PG8_BAR;
        PG8_WAIT_V(2); PG8_BAR;
        PG8_STAGE(PG8_SB(1, 0), cB + kstep, voffB); PG8_STAGE(PG8_SA(1, 0), cA + kstepA, voffA); PG8_STAGE(PG8_SB(1, 1), cB + hstepB + kstep, voffB);
        PG8_WAIT_V(6); PG8_BAR;
    } else {
        PG8_STAGE(PG8_SB(0, 0), cB, voffB); PG8_STAGE(PG8_SA(0, 0), cA, voffA); PG8_STAGE(PG8_SB(0, 1), cB + hstepB, voffB); PG8_STAGE(PG8_SA(0, 1), cA + hstepA, voffA);
        if (wr == 1) PG8_BAR;
        PG8_WAIT_V(4); PG8_BAR;
        PG8_STAGE(PG8_SB(1, 0), cB + kstep, voffB); PG8_STAGE(PG8_SA(1, 0), cA + kstepA, voffA); PG8_STAGE(PG8_SB(1, 1), cB + hstepB + kstep, voffB);
        PG8_WAIT_V(6); PG8_BAR;
    }
    for (;;) {
        const bool has_next = S.next(ui + 1, nxt);
        const char* nA = has_next ? (const char*)g.A + (size_t)(nxt.pm & g.pm_mask) * tstep : cA; const char* nB = has_next ? (const char*)g.Bt + (size_t)(nxt.pn & g.pn_mask) * tstep : cB;
        for (int t = 0; t < nt; t += 2) {
            if constexpr (Epi::HAS_MID) { if (t == Epi::MID_T) E.mid(acc, cur, wr, wc, fr, fq); }
            const bool last = (t == nt - 2);
            const char* a1 = cA + (size_t)(t + 1) * kstepA;
            const char* a2 = last ? nA : cA + (size_t)(t + 2) * kstepA; const char* b2 = last ? nB : cB + (size_t)(t + 2) * kstep;
            const char* a3 = a2 + kstepA; const char* b3 = b2 + kstep;
            if (last && has_next) S.a_ready(nxt);
            if constexpr (SP2) {
            PG8_LDB(B0, 0, 0); PG8_LDB(B1, 0, 1); PG8_SCHED; PG8_LDA(At, 0, 0); PG8_STAGE(PG8_SA(1, 1), a1 + hstepA, voffA);
            PG8_WAIT_V(8); PG8_WAIT_L(0); PG8_BAR; PG8_MMA(0, 0, At, B0); PG8_MMA(0, 1, At, B1); PG8_BAR; PG8_SCHED;
            PG8_LDA(At, 0, 1); PG8_STAGE(PG8_SB(0, 0), b2, voffB); PG8_STAGE(PG8_SB(0, 1), b2 + hstepB, voffB); PG8_STAGE(PG8_SA(0, 0), a2, voffA);
            PG8_WAIT_V(8); PG8_WAIT_L(0); PG8_BAR; PG8_MMA(1, 0, At, B0); PG8_MMA(1, 1, At, B1); PG8_BAR; PG8_SCHED;
            PG8_LDB(B0, 1, 0); PG8_LDB(B1, 1, 1); PG8_SCHED; PG8_LDA(At, 1, 0); PG8_STAGE(PG8_SA(0, 1), a2 + hstepA, voffA);
            PG8_WAIT_V(8); PG8_WAIT_L(0); PG8_BAR; PG8_MMA(0, 0, At, B0); PG8_MMA(0, 1, At, B1); PG8_BAR; PG8_SCHED;
            PG8_LDA(At, 1, 1); PG8_STAGE(PG8_SB(1, 0), b3, voffB); PG8_STAGE(PG8_SB(1, 1), b3 + hstepB, voffB); PG8_STAGE(PG8_SA(1, 0), a3, voffA);
            PG8_WAIT_V(8); PG8_WAIT_L(0); PG8_BAR; PG8_MMA(1, 0, At, B0); PG8_MMA(1, 1, At, B1); PG8_BAR; PG8_SCHED;
            } else {
            PG8_LDB(B0, 0, 0); PG8_SCHED; PG8_LDA(At, 0, 0); PG8_STAGE(PG8_SA(1, 1), a1 + hstepA, voffA);
            PG8_WAIT_L(8); PG8_BAR; PG8_WAIT_L(0); PG8_MMA(0, 0, At, B0); PG8_BAR; PG8_SCHED;
            PG8_LDB(B1, 0, 1); PG8_STAGE(PG8_SB(0, 0), b2, voffB);
            PG8_BAR; PG8_WAIT_L(0); PG8_MMA(0, 1, At, B1); PG8_BAR;
            PG8_LDA(At, 0, 1); PG8_STAGE(PG8_SA(0, 0), a2, voffA);
            PG8_BAR; PG8_WAIT_L(0); PG8_MMA(1, 0, At, B0); PG8_BAR; PG8_SCHED;
            PG8_STAGE(PG8_SB(0, 1), b2 + hstepB, voffB);
            PG8_WAIT_V(6); PG8_BAR; PG8_MMA(1, 1, At, B1); PG8_BAR;
            PG8_LDB(B0, 1, 0); PG8_SCHED; PG8_LDA(At, 1, 0); PG8_STAGE(PG8_SA(0, 1), a2 + hstepA, voffA);
            PG8_WAIT_L(8); PG8_BAR; PG8_WAIT_L(0); PG8_MMA(0, 0, At, B0); PG8_BAR; PG8_SCHED;
            PG8_LDB(B1, 1, 1); PG8_STAGE(PG8_SB(1, 0), b3, voffB);
            PG8_BAR; PG8_WAIT_L(0); PG8_MMA(0, 1, At, B1); PG8_BAR;
            PG8_LDA(At, 1, 1); PG8_STAGE(PG8_SA(1, 0), a3, voffA);
            PG8_BAR; PG8_WAIT_L(0); PG8_MMA(1, 0, At, B0); PG8_BAR; PG8_SCHED;
            PG8_STAGE(PG8_SB(1, 1), b3 + hstepB, voffB);
            PG8_WAIT_V(6); PG8_BAR; PG8_MMA(1, 1, At, B1); PG8_BAR;
            }
        }
        if constexpr (ALIGN_EPI) { if (wr == 0) PG8_BAR; }
        if constexpr (!Epi::AFTER_DRAIN) { E(acc, cur, wr, wc, fr, fq); S.done(cur); }
        if (!has_next) break;
#pragma unroll
        for (int a = 0; a < 2; ++a)
#pragma unroll
            for (int b = 0; b < 2; ++b)
#pragma unroll
                for (int m = 0; m < 4; ++m)
#pragma unroll
                    for (int n = 0; n < 2; ++n) acc[a][b][m][n] = (f32x4){0.f, 0.f, 0.f, 0.f};
        cur = nxt; cA = nA; cB = nB; ++ui;
        if constexpr (ALIGN_EPI) { if (wr == 1) PG8_BAR; }
    }
    PG8_WAIT_V(0);
    if constexpr (!ALIGN_EPI) { if (wr == 0) PG8_BAR; }
    PG8_BAR;
    if constexpr (Epi::AFTER_DRAIN) { E.fused(acc, cur, wr, wc, fr, fq, lds, wid, lane); S.done(cur); }
#undef PG8_SA
#undef PG8_SB
#undef PG8_STAGE
#undef PG8_LDA
#undef PG8_LDB
#undef PG8_MMA
#undef PG8_WAIT_V
#undef PG8_WAIT_L
#undef PG8_BAR
#undef PG8_SCHED
}
}
#define GAS __attribute__((address_space(1)))
#define LAS __attribute__((address_space(3)))
typedef unsigned short bf16;
typedef unsigned v4u __attribute__((ext_vector_type(4)));
typedef float f32x4 __attribute__((ext_vector_type(4)));
typedef short bf16x8 __attribute__((ext_vector_type(8)));
typedef GAS unsigned gu32;
typedef GAS unsigned long long gu64;
#define RLX_AGENT __ATOMIC_RELAXED, __HIP_MEMORY_SCOPE_AGENT
#define LDS_WAIT() asm volatile("s_waitcnt lgkmcnt(0)" ::: "memory")
#define VM_WAIT() asm volatile("s_waitcnt vmcnt(0)" ::: "memory")
__device__ __forceinline__ unsigned long long rt() { return __builtin_amdgcn_s_memrealtime(); }
__device__ __forceinline__ unsigned f2bf(float f) { unsigned u = __builtin_bit_cast(unsigned, f); return (u + 0x7fffu + ((u >> 16) & 1u)) >> 16; }
__device__ __forceinline__ unsigned pk2(float lo, float hi) { return f2bf(lo) | (f2bf(hi) << 16); }

#define XB_TMO      128
#define XB_XCNT(j)  (256  + 64 * (j))
#define XB_XSUB(j)  (1280 + 64 * (j))
#define XB_XGEN(j)  (2304 + 64 * (j))
#define XB_TOP      3328
#define XB_TOPGEN   3392
#define XCD_BAR_WORDS 3456
#define XB_SPIN_CAP (1u << 18)

__device__ __forceinline__ unsigned xb_ld(unsigned* p)              { return __hip_atomic_load(p, __ATOMIC_RELAXED, __HIP_MEMORY_SCOPE_AGENT); }
__device__ __forceinline__ unsigned xb_add(unsigned* p, unsigned v) { return __hip_atomic_fetch_add(p, v, __ATOMIC_RELAXED, __HIP_MEMORY_SCOPE_AGENT); }
__device__ __forceinline__ unsigned xb_xcc_id() { return (unsigned)__builtin_amdgcn_s_getreg((3 << 11) | 20) & 0xFu; }
#define XB_SPIN(cond, bar) do { unsigned _sp = 0; while (cond) { __builtin_amdgcn_s_sleep(1); \
    if ((++_sp & 255u) == 0u) { if (xb_ld(&(bar)[XB_TMO])) break; if (_sp > XB_SPIN_CAP) { atomicAdd(&(bar)[XB_TMO], 1u); break; } } } } while (0)

struct XcdBarrier {
    unsigned* bar; unsigned x;
    volatile LAS unsigned* st;
};

__device__ __forceinline__ XcdBarrier xcd_barrier_post(unsigned* bar, volatile LAS unsigned* st) {
    XcdBarrier b; b.bar = bar; b.x = xb_xcc_id(); b.st = st;
    if (threadIdx.x == 0) (void)xb_add(&bar[XB_XCNT(b.x)], 1u);
    return b;
}
__device__ __forceinline__ void xcd_barrier_complete(unsigned* bar, unsigned x, unsigned& nloc, unsigned& nx) {
    const unsigned G = gridDim.x * gridDim.y * gridDim.z;
    unsigned sum, cnt, mine, sp = 0u;
    for (;;) {
        sum = 0u; cnt = 0u; mine = 0u;
#pragma unroll
        for (unsigned j = 0; j < 16; ++j) { const unsigned c = xb_ld(&bar[XB_XCNT(j)]); sum += c; cnt += (c > 0u) ? 1u : 0u; mine = (j == x) ? c : mine; }
        if (sum == G) break;
        __builtin_amdgcn_s_sleep(1);
        if ((++sp & 255u) == 0u) { if (xb_ld(&bar[XB_TMO])) break; if (sp > XB_SPIN_CAP) { atomicAdd(&bar[XB_TMO], 1u); break; } }
    }
    nloc = mine > 0u ? mine : 1u; nx = cnt > 0u ? cnt : 1u;
}

__device__ __forceinline__ void xcd_barrier(const XcdBarrier& b) {
    asm volatile("s_waitcnt vmcnt(0)" ::: "memory");
    __syncthreads();
    if (threadIdx.x == 0) {
        unsigned* bar = b.bar;
        __builtin_amdgcn_s_waitcnt(0);
        unsigned nloc = b.st[0], nx = b.st[1];
        if (nloc == 0u) { xcd_barrier_complete(bar, b.x, nloc, nx); b.st[0] = nloc; b.st[1] = nx; }
        const unsigned old = xb_add(&bar[XB_XSUB(b.x)], 1u);
        const unsigned gen = old / nloc;
        if (old + 1u == (gen + 1u) * nloc) {
            __builtin_amdgcn_fence(__ATOMIC_RELEASE, "agent");
            asm volatile("s_waitcnt vmcnt(0)" ::: "memory");
            const unsigned og = xb_add(&bar[XB_TOP], 1u);
            const unsigned tg = og / nx;
            if (og + 1u == (tg + 1u) * nx) xb_add(&bar[XB_TOPGEN], 1u);
            else XB_SPIN(xb_ld(&bar[XB_TOPGEN]) == tg, bar);
            __builtin_amdgcn_fence(__ATOMIC_ACQUIRE, "agent");
            xb_add(&bar[XB_XGEN(b.x)], 1u);
            asm volatile("s_waitcnt vmcnt(0)" ::: "memory");
        } else {
            XB_SPIN(xb_ld(&bar[XB_XGEN(b.x)]) == gen, bar);
            __builtin_amdgcn_fence(__ATOMIC_ACQUIRE, "agent");
            asm volatile("s_waitcnt vmcnt(0)" ::: "memory");
        }
    }
    __syncthreads();
}

constexpr int NWAVES = 8;
#ifndef MK_N_LAUNCHES
#define MK_N_LAUNCHES 1
#endif
#ifndef PROBE_DUP
#define PROBE_DUP 0
#endif
#define NREP(k) (1 + ((PROBE_DUP >> (k)) & 1))
#ifndef PROBE_T
#define PROBE_T -1
#endif
#define PROBE_MULT 4
#ifndef PROBE_BLK
#define PROBE_BLK 0
#endif
constexpr int N_LAUNCHES = MK_N_LAUNCHES;
constexpr int PER_PHASE = 9;
constexpr int MP = 65536, MS = 1024, MT = 66560, DM = 1024, PW = 5888, FF = 4096;
constexpr float EPS = 1e-6f, LOG2E = 1.4426950408889634f;
constexpr size_t MiB = 1u << 20;
constexpr size_t WS_CTL = 0, CTL_ZERO_BYTES = 1 * MiB;
constexpr size_t WS_WIN = 2 * MiB, WS_WAC = 14 * MiB, WS_WO = 16 * MiB, WS_W1 = 18 * MiB, WS_W2 = 26 * MiB;
constexpr size_t WS_RSTD0 = 34 * MiB, WS_SSQ1 = 35 * MiB, WS_LSE = 40 * MiB, WS_BIAST = 45 * MiB;
constexpr size_t WS_SQ = 46 * MiB;
constexpr size_t WS_XB = 52 * MiB;
constexpr size_t WS_CBU = 182 * MiB;
constexpr size_t WS_GT = 312 * MiB;
constexpr size_t WS_QKV = 572 * MiB;
constexpr size_t WS_AB = 860 * MiB;
constexpr size_t WS_MB = 958 * MiB;
constexpr size_t WS_HID = 1088 * MiB;
constexpr size_t WS_SOG = 1608 * MiB;
constexpr size_t WS_END = 1612 * MiB;
static_assert(WS_WIN + (size_t)PW * DM * 2 <= WS_WAC && WS_SSQ1 + (size_t)MT * 64 <= WS_LSE && WS_LSE + (size_t)3 * MT * 16 <= WS_BIAST && WS_SQ + (size_t)MS * 2304 * 2 <= WS_XB && WS_XB + (size_t)MT * DM * 2 <= WS_CBU && WS_CBU + (size_t)MT * DM * 2 <= WS_GT
              && WS_GT + (size_t)260 * 4 * 2 * 65536 * 2 <= WS_QKV && WS_QKV + (size_t)3 * MP * 768 * 2 <= WS_AB && WS_AB + (size_t)MT * 768 * 2 <= WS_MB && WS_MB + (size_t)MT * DM * 2 <= WS_HID && WS_HID + (size_t)MT * FF * 2 <= WS_END, "d_ws map");
constexpr int CW_BAR = 4096;
constexpr int RING_OFF = 0, RING_BYTES = 131072;
constexpr int LDSCTL_OFF = 143360, MISC_OFF = LDSCTL_OFF + 320;
constexpr int LDS_BYTES = 163840, EPI_STAGE_OFF = 147456;
static_assert(MISC_OFF + 128 <= LDS_BYTES, "LDS map");

__constant__ unsigned char BUCKETS[3][132] = {
 {0,1,2,3,4,5,6,7,8,9,10,11,12,13,14,15,16,16,16,16,16,16,17,17,17,17,17,17,17,17,18,18,18,18,18,18,18,18,18,18,19,19,19,19,19,19,19,19,19,19,19,19,19,19,20,20,20,20,20,20,20,20,20,20,20,20,20,20,20,20,20,20,20,21,21,21,21,21,21,21,21,21,21,21,21,21,21,21,21,21,21,21,21,21,21,21,21,21,21,22,22,22,22,22,22,22,22,22,22,22,22,22,22,22,22,22,22,22,22,22,22,22,22,22,22,22,22,22,22,0,0,0},
 {0,4,8,12,16,16,17,17,18,18,19,19,19,19,20,20,20,20,20,21,21,21,21,21,21,22,22,22,22,22,22,22,22,22,23,23,23,23,23,23,23,23,23,23,23,23,24,24,24,24,24,24,24,24,24,24,24,24,24,24,24,24,25,25,25,25,25,25,25,25,25,25,25,25,25,25,25,25,25,25,25,25,25,26,26,26,26,26,26,26,26,26,26,26,26,26,26,26,26,26,26,26,26,26,26,26,26,26,26,26,26,26,26,27,27,27,27,27,27,27,27,27,27,27,27,27,27,27,27,0,0,0},
 {0,16,18,19,20,21,21,22,22,23,23,23,24,24,24,24,25,25,25,25,25,26,26,26,26,26,26,26,26,27,27,27,27,27,27,27,27,27,27,28,28,28,28,28,28,28,28,28,28,28,28,28,29,29,29,29,29,29,29,29,29,29,29,29,29,29,29,29,29,29,30,30,30,30,30,30,30,30,30,30,30,30,30,30,30,30,30,30,30,30,30,30,30,30,30,31,31,31,31,31,31,31,31,31,31,31,31,31,31,31,31,31,31,31,31,31,31,31,31,31,31,31,31,31,31,31,31,31,31,0,0,0}};

struct Frame {
    LAS unsigned char* lds;
    volatile LAS unsigned* MISC;
    gu32* ctl;
    int tid, lane, wave;
    int vcu, G;
    const float *xp, *xs, *sconv, *w_in, *w_ao, *w_co, *w_o, *conv_w, *conv_b, *rel_bias, *g_mix, *g_mlp, *w_ff1, *w_ff2, *g_fin;
    float* out;
    bf16 *WIN_T, *WAC_T, *WO_T, *W1_T, *W2_T, *XB, *HID, *AB, *MB, *OG, *QKV, *SQ, *CBU, *GT, *SOG;
    float *RSTD0, *SSQ1, *BIAST, *LSE, *SLSE;
};

__device__ __forceinline__ float wave_sum(float v) {
#pragma unroll
    for (int o = 1; o < 64; o <<= 1) v += __shfl_xor(v, o);
    return v;
}
__device__ __forceinline__ int win_src_col(int n) {
    if (n < 2816) return n;
    const int base = n < 3840 ? 2816 : 3840, q = (n - base) >> 8, p = (n - base) & 255, w = p >> 6, h = (p >> 5) & 1, o = p & 31;
    if (n < 3840) return (h ? 3328 : 2816) + 128 * q + 32 * w + o;
    return (h ? 4864 : 3840) + 256 * (q >> 1) + 64 * w + 32 * (q & 1) + o;
}
__device__ __forceinline__ void p0_transpose_item(const float* W, int N, bf16* WT, int ldT, int koff, const float* kscale, LAS float* scr, int item, int lane, bool perm = false) {
    const int nblk = N / 32, kb = item / nblk, nb = item % nblk, k0 = 64 * kb, n0 = 32 * nb, ns0 = perm ? win_src_col(n0) : n0;
    float wv[32];
#pragma unroll
    for (int i = 0; i < 32; ++i) wv[i] = W[(size_t)(k0 + 2 * i + (lane >> 5)) * N + ns0 + (lane & 31)];
#pragma unroll
    for (int i = 0; i < 32; ++i) { const int kk = 2 * i + (lane >> 5); const float sc = kscale ? kscale[k0 + kk] : 1.f; scr[kk * 33 + (lane & 31)] = wv[i] * sc; }
    LDS_WAIT(); asm volatile("" ::: "memory");
    const int c = lane & 7;
#pragma unroll
    for (int j = 0; j < 4; ++j) { const int n = (lane >> 3) + 8 * j; const LAS float* s = scr + (8 * c) * 33 + n;
        v4u o; o.x = pk2(s[0 * 33], s[1 * 33]); o.y = pk2(s[2 * 33], s[3 * 33]); o.z = pk2(s[4 * 33], s[5 * 33]); o.w = pk2(s[6 * 33], s[7 * 33]);
        *(GAS v4u*)(WT + (size_t)(n0 + n) * ldT + koff + k0 + 8 * c) = o; }
    LDS_WAIT(); asm volatile("" ::: "memory");
}
template <int NR> __device__ __forceinline__ void p0_load(Frame& F, f32x4 (&v)[NR][4], int m0, int mstride) {
#pragma unroll
    for (int r = 0; r < NR; ++r) { int m = m0 + r * mstride; m = m < MT ? m : MT - 1; const GAS f32x4* xr = (const GAS f32x4*)(m < MP ? F.xp + (size_t)m * DM : F.xs + (size_t)(m - MP) * DM) + F.lane;
#pragma unroll
        for (int j = 0; j < 4; ++j) v[r][j] = xr[64 * j]; }
}
template <int NR> __device__ __forceinline__ void p0_proc(Frame& F, const f32x4 (&v)[NR][4], int m0, int mstride) {
#pragma unroll
    for (int r = 0; r < NR; ++r) { const int m = m0 + r * mstride; if (m < MT) { float s = 0.f;
#pragma unroll
        for (int j = 0; j < 4; ++j) s += (v[r][j].x * v[r][j].x + v[r][j].y * v[r][j].y) + (v[r][j].z * v[r][j].z + v[r][j].w * v[r][j].w);
        const float tot = wave_sum(s), nrm = sqrtf(tot * (1.f / DM) + EPS), rs = 1.0f / nrm;
        GAS unsigned long long* o8 = (GAS unsigned long long*)(F.XB + (size_t)m * DM) + F.lane;
#pragma unroll
        for (int j = 0; j < 4; ++j) o8[64 * j] = (unsigned long long)pk2(v[r][j].x * rs, v[r][j].y * rs) | ((unsigned long long)pk2(v[r][j].z * rs, v[r][j].w * rs) << 32);
        if (F.lane == 0) F.RSTD0[m] = nrm; } }
}
__device__ __forceinline__ void p0_rowpass(Frame& F, int gw, int NGW) {
    constexpr int NR = 4; f32x4 va[NR][4], vb[NR][4];
    int m = gw; if (m >= MT) return;
    p0_load<NR>(F, va, m, NGW);
    for (;;) {
        const int m1 = m + NR * NGW; const bool more1 = m1 < MT;
        if (more1) p0_load<NR>(F, vb, m1, NGW);
        p0_proc<NR>(F, va, m, NGW);
        if (!more1) break;
        const int m2 = m1 + NR * NGW; const bool more2 = m2 < MT;
        if (more2) p0_load<NR>(F, va, m2, NGW);
        p0_proc<NR>(F, vb, m1, NGW);
        if (!more2) break;
        m = m2;
    }
}
__device__ __forceinline__ void p0_prologue(Frame& F) {
    LAS float* scr = (LAS float*)(F.lds + RING_OFF + F.wave * 16384);
    const int gw = F.vcu * NWAVES + F.wave, NGW = F.G * NWAVES;
    constexpr int I_IN = (DM / 64) * (PW / 32);
    for (int it = gw; it < I_IN; it += NGW) p0_transpose_item(F.w_in, PW, F.WIN_T, DM, 0, F.g_mix, scr, it, F.lane, true);
    p0_rowpass(F, gw, NGW);
    for (int i = gw * 64 + F.lane; i < 12 * 132; i += NGW * 64) { const int gh = i / 132, j = i % 132, g = gh >> 2; F.BIAST[i] = j <= 128 ? F.rel_bias[(int)BUCKETS[g][j] * 12 + gh] * LOG2E : 0.f; }
}
__device__ __forceinline__ void p1_tail_weights(Frame& F, int wk, int nwk) {
    LAS float* scr = (LAS float*)(F.lds + RING_OFF + F.wave * 16384);
    constexpr int I_AO = (256 / 64) * (DM / 32), I_CO = (512 / 64) * (DM / 32), I_O = (DM / 64) * (DM / 32), I_1 = (DM / 64) * (FF / 32), I_2 = (FF / 64) * (DM / 32);
    constexpr int NITEMS = I_AO + I_CO + I_O + I_1 + I_2;
    for (int it = wk; it < NITEMS; it += nwk) {
        int r = it;
        if (r < I_AO) { p0_transpose_item(F.w_ao, DM, F.WAC_T, 768, 0, nullptr, scr, r, F.lane); continue; } r -= I_AO;
        if (r < I_CO) { p0_transpose_item(F.w_co, DM, F.WAC_T, 768, 256, nullptr, scr, r, F.lane); continue; } r -= I_CO;
        if (r < I_O) { p0_transpose_item(F.w_o, DM, F.WO_T, DM, 0, nullptr, scr, r, F.lane); continue; } r -= I_O;
        if (r < I_1) { p0_transpose_item(F.w_ff1, FF, F.W1_T, DM, 0, F.g_mlp, scr, r, F.lane); continue; } r -= I_1;
        p0_transpose_item(F.w_ff2, DM, F.W2_T, FF, 0, nullptr, scr, r, F.lane);
    }
}

__device__ __forceinline__ void ld_bf4(const bf16* p, float& a, float& b, float& c, float& d) { const uint2 w = *(const uint2*)p; a = __uint_as_float(w.x << 16); b = __uint_as_float(w.x & 0xffff0000u); c = __uint_as_float(w.y << 16); d = __uint_as_float(w.y & 0xffff0000u); }
__device__ __forceinline__ void ld_bf8(const bf16* p, float (&o)[8]) { const v4u w = *(const v4u*)p;
#pragma unroll
    for (int i = 0; i < 4; ++i) { o[2 * i] = __uint_as_float(w[i] << 16); o[2 * i + 1] = __uint_as_float(w[i] & 0xffff0000u); } }
typedef float f32x16 __attribute__((ext_vector_type(16)));
typedef short s16x4 __attribute__((ext_vector_type(4)));
typedef short v4i16_t __attribute__((ext_vector_type(4)));
constexpr int TB_N = 256;
constexpr int P2_TB_OFF = 0, P2_VST_OFF = 16384;
__device__ __forceinline__ s16x4 vtr(const LAS unsigned char* p) { return __builtin_bit_cast(s16x4, __builtin_amdgcn_ds_read_tr16_b64_v4i16((LAS v4i16_t*)p)); }
__device__ __forceinline__ unsigned cvtpk(float lo, float hi) { unsigned r; asm volatile("v_cvt_pk_bf16_f32 %0, %1, %2" : "=v"(r) : "v"(lo), "v"(hi)); return r; }
__device__ __forceinline__ void attn_unit(Frame& F, int w) {
    const int lane = F.lane, r32 = lane & 31, hi = lane >> 5;
    const int qlin = w & 255, h = (w >> 8) & 3, bg = w >> 10, g = bg % 3, b = bg / 3;
    const int sh = 2 * g, nql = 8 - sh, r = qlin >> nql, qb = qlin & ((1 << nql) - 1);
    const bf16* base = F.QKV + ((size_t)((b * 3 + g) * 4 + h) * 8192 + (size_t)r * (8192 >> sh)) * 64;
    constexpr size_t lstride = 64, KOFF = (size_t)MP * 768;
    const LAS float* tbg = (const LAS float*)(F.lds + P2_TB_OFF) + (g * 4 + h) * TB_N + (r32 - 4 * hi);
    LAS unsigned char* vst = F.lds + P2_VST_OFF + F.wave * 8192;
    bf16x8 qf[4], kf[5][4];
    { const bf16* qp = base + (size_t)(32 * qb + r32) * lstride + hi * 8;
#pragma unroll
      for (int d0 = 0; d0 < 4; ++d0) qf[d0] = *(const bf16x8*)(qp + d0 * 16); }
#pragma unroll
    for (int kt = 0; kt < 5; ++kt) {
        const int tix = qb - 4 + kt < 0 ? 0 : qb - 4 + kt;
        const bf16* kp = base + KOFF + (size_t)(32 * tix + r32) * lstride + hi * 8;
#pragma unroll
        for (int d0 = 0; d0 < 4; ++d0) kf[kt][d0] = *(const bf16x8*)(kp + d0 * 16);
    }
    v4u vv[5][4];
#define P2_VLOAD(kt) do { const int tix_ = qb - 4 + (kt) < 0 ? 0 : qb - 4 + (kt); const bf16* vp_ = base + 2 * KOFF + (size_t)(32 * tix_ + (lane >> 2)) * lstride + (lane & 3) * 8; \
        _Pragma("unroll") for (int pc = 0; pc < 4; ++pc) vv[kt][pc] = *(const v4u*)(vp_ + (size_t)((pc & 1) * 16) * lstride + (pc >> 1) * 32); } while (0)
    P2_VLOAD(0); P2_VLOAD(1);
    asm volatile("" ::: "memory");
    f32x16 s[5];
#pragma unroll
    for (int kt = 0; kt < 5; ++kt) {
        const LAS float* tb = tbg + ((qb - 4 + kt < 0) ? 223 : 160 - 32 * kt);
        f32x16 c;
#pragma unroll
        for (int i = 0; i < 16; ++i) c[i] = tb[-(i & 3) - 8 * (i >> 2)];
#pragma unroll
        for (int d0 = 0; d0 < 4; ++d0) c = __builtin_amdgcn_mfma_f32_32x32x16_bf16(kf[kt][d0], qf[d0], c, 0, 0, 0);
        s[kt] = c;
    }
    P2_VLOAD(2); P2_VLOAD(3); P2_VLOAD(4);
    asm volatile("" ::: "memory");
#undef P2_VLOAD
    float mx = -INFINITY;
#pragma unroll
    for (int kt = 0; kt < 5; ++kt)
#pragma unroll
        for (int i = 0; i < 16; ++i) mx = fmaxf(mx, s[kt][i]);
    mx = fmaxf(mx, __shfl_xor(mx, 32));
    float ls = 0.f;
#pragma unroll
    for (int kt = 0; kt < 5; ++kt)
#pragma unroll
        for (int i = 0; i < 16; ++i) { const float p = __builtin_amdgcn_exp2f(s[kt][i] - mx); s[kt][i] = p; ls += p; }
    ls += __shfl_xor(ls, 32);
    f32x16 ot[2];
#pragma unroll
    for (int i = 0; i < 16; ++i) { ot[0][i] = 0.f; ot[1][i] = 0.f; }
    const int ltr = ((lane >> 4) & 1) * 32 + (lane & 3) * 8 + (4 * hi + ((lane & 15) >> 2)) * 64;
#pragma unroll
    for (int kt = 0; kt < 5; ++kt) {
        LAS unsigned char* vb = vst + (kt & 1) * 4096;
#pragma unroll
        for (int pc = 0; pc < 4; ++pc) *(LAS v4u*)(vb + pc * 1024 + lane * 16) = vv[kt][pc];
#pragma unroll
        for (int ks = 0; ks < 2; ++ks) {
            v4u pw; pw.x = cvtpk(s[kt][8 * ks + 0], s[kt][8 * ks + 1]); pw.y = cvtpk(s[kt][8 * ks + 2], s[kt][8 * ks + 3]); pw.z = cvtpk(s[kt][8 * ks + 4], s[kt][8 * ks + 5]); pw.w = cvtpk(s[kt][8 * ks + 6], s[kt][8 * ks + 7]);
            const bf16x8 pf = __builtin_bit_cast(bf16x8, pw);
#pragma unroll
            for (int d0 = 0; d0 < 2; ++d0) {
                const s16x4 lo = vtr(vb + (d0 * 2 + ks) * 1024 + ltr), hh = vtr(vb + (d0 * 2 + ks) * 1024 + ltr + 512);
                const bf16x8 vf = (bf16x8){lo[0], lo[1], lo[2], lo[3], hh[0], hh[1], hh[2], hh[3]};
                ot[d0] = __builtin_amdgcn_mfma_f32_32x32x16_bf16(vf, pf, ot[d0], 0, 0, 0);
            }
        }
    }
    const float inv = 1.f / ls;
    const size_t row = (size_t)b * 8192 + ((size_t)(32 * qb + r32) << sh) + r;
    bf16* op = F.OG + ((size_t)g * MT + row) * 256 + h * 64 + 4 * hi;
#pragma unroll
    for (int d0 = 0; d0 < 2; ++d0)
#pragma unroll
        for (int i = 0; i < 4; ++i)
            *(uint2*)(op + d0 * 32 + 8 * i) = make_uint2(cvtpk(ot[d0][4 * i] * inv, ot[d0][4 * i + 1] * inv), cvtpk(ot[d0][4 * i + 2] * inv, ot[d0][4 * i + 3] * inv));
    if (hi == 0) F.LSE[((size_t)g * MT + row) * 4 + h] = mx + __builtin_amdgcn_logf(ls);
}
__device__ __forceinline__ void samp_unit(Frame& F, const float* const* caches, int su2) {
    const int l = F.lane, h = l >> 4;
    const int half = su2 & 1, su = su2 >> 1, t = su & 7, bg = su >> 3, g = bg % 3, b = bg / 3;
    const int sh = 2 * g, dil = 1 << sh, win = 128 << sh;
    const bf16* sq = F.SQ + (size_t)(b * 8 + t) * 2304 + g * 256 + 4 * l;
    float q0, q1, q2, q3; ld_bf4(sq, q0, q1, q2, q3);
    const float* bias = F.BIAST + (g * 4 + h) * 132;
    const float* cache = caches[g] + (size_t)b * win * 512 + 4 * l;
    float mx = -1e30f, ls = 0.f, o0 = 0.f, o1 = 0.f, o2 = 0.f, o3 = 0.f;
    const int jn = (t >> sh) + 1;
    const int jlo = half ? 65 : jn, jhi = half ? 128 : 64;
    f32x4 ka[8], va[8], kb[8], vb[8];
#define SU_LOAD(K_, V_, j0_) do { _Pragma("unroll") for (int u = 0; u < 8; ++u) { const int j = (j0_) + u <= jhi ? (j0_) + u : jhi; const float* kp = cache + (size_t)(win + t - j * dil) * 512; K_[u] = *(const f32x4*)kp; V_[u] = *(const f32x4*)(kp + 256); } } while (0)
#define SU_USE(K_, V_, j0_) do { float sc[8]; \
        _Pragma("unroll") for (int u = 0; u < 8; ++u) { float p = (q0 * K_[u].x + q1 * K_[u].y) + (q2 * K_[u].z + q3 * K_[u].w); \
            p += __shfl_xor(p, 1); p += __shfl_xor(p, 2); p += __shfl_xor(p, 4); p += __shfl_xor(p, 8); sc[u] = ((j0_) + u <= jhi) ? p + bias[(j0_) + u] : -INFINITY; } \
        float mn = mx; _Pragma("unroll") for (int u = 0; u < 8; ++u) mn = fmaxf(mn, sc[u]); \
        const float al = __builtin_amdgcn_exp2f(mx - mn); ls *= al; o0 *= al; o1 *= al; o2 *= al; o3 *= al; \
        _Pragma("unroll") for (int u = 0; u < 8; ++u) { const float e = __builtin_amdgcn_exp2f(sc[u] - mn); ls += e; o0 += e * V_[u].x; o1 += e * V_[u].y; o2 += e * V_[u].z; o3 += e * V_[u].w; } \
        mx = mn; } while (0)
    SU_LOAD(ka, va, jlo);
    if (!half) for (int j = 0; j < jn; ++j) {
        const bf16* kp = sq - (size_t)(j * dil) * 2304 + 768;
        float k0, k1, k2, k3, v0, v1, v2, v3; ld_bf4(kp, k0, k1, k2, k3); ld_bf4(kp + 768, v0, v1, v2, v3);
        float p = (q0 * k0 + q1 * k1) + (q2 * k2 + q3 * k3);
        p += __shfl_xor(p, 1); p += __shfl_xor(p, 2); p += __shfl_xor(p, 4); p += __shfl_xor(p, 8);
        const float sc = p + bias[j], mn = fmaxf(mx, sc), al = __builtin_amdgcn_exp2f(mx - mn), e = __builtin_amdgcn_exp2f(sc - mn);
        ls = ls * al + e; o0 = o0 * al + e * v0; o1 = o1 * al + e * v1; o2 = o2 * al + e * v2; o3 = o3 * al + e * v3; mx = mn;
    }
    for (int j0 = jlo; j0 <= jhi; j0 += 16) {
        if (j0 + 8 <= jhi) SU_LOAD(kb, vb, j0 + 8);
        SU_USE(ka, va, j0);
        if (j0 + 8 <= jhi) { if (j0 + 16 <= jhi) SU_LOAD(ka, va, j0 + 16); SU_USE(kb, vb, j0 + 8); }
    }
#undef SU_LOAD
#undef SU_USE
    const float inv = 1.f / ls;
    const size_t prow = (size_t)(g * 2 + half) * MS + (b * 8 + t);
    *(uint2*)(F.SOG + prow * 256 + 4 * l) = make_uint2(pk2(o0 * inv, o1 * inv), pk2(o2 * inv, o3 * inv));
    if ((l & 15) == 0) F.SLSE[prow * 4 + h] = mx + __builtin_amdgcn_logf(ls);
}
constexpr int PC_TB = 0, PC_K = 12288, PC_V = PC_K + 49152, PC_Q = PC_V + 49152;
static_assert(PC_Q + 32768 <= LDSCTL_OFF, "attention LDS map");
__device__ __forceinline__ void glds16(const void* gsrc, unsigned lds_dst) { unsigned keep;
    asm volatile("s_mov_b32 %0, m0\n\ts_mov_b32 m0, %2\n\ts_nop 0\n\tglobal_load_lds_dwordx4 %1, off\n\ts_mov_b32 m0, %0" : "=&s"(keep) : "v"(gsrc), "s"(lds_dst) : "memory"); }
#define PC_WAIT_BAR() asm volatile("s_waitcnt vmcnt(0) lgkmcnt(0)\n\ts_barrier" ::: "memory")
struct PcUnit { const bf16* base; int qb0, g, h, sh; size_t row0; };
__device__ __forceinline__ PcUnit pc_decode(Frame& F, int grp) {
    PcUnit u; const int w0 = grp * 8, qlin = w0 & 255; u.h = (w0 >> 8) & 3; const int bg = w0 >> 10; u.g = bg % 3; const int b = bg / 3;
    u.sh = 2 * u.g; const int nql = 8 - u.sh, r = qlin >> nql; u.qb0 = qlin & ((1 << nql) - 1);
    u.base = F.QKV + ((size_t)((b * 3 + u.g) * 4 + u.h) * 8192 + (size_t)r * (8192 >> u.sh)) * 64; u.row0 = (size_t)b * 8192 + r; return u;
}
__device__ __forceinline__ void pc_dma_k(Frame& F, const PcUnit& u, unsigned ldsb) {
    constexpr size_t KOFF = (size_t)MP * 768;
    const int rl = F.lane >> 3, cs = F.lane & 7;
#pragma unroll
    for (int i = 0; i < 6; ++i) { const int idx = F.wave * 6 + i, sl = idx >> 2, p = idx & 3; int tix = u.qb0 - 4 + sl; tix = tix < 0 ? 0 : tix; const int row = 8 * p + rl;
        glds16(u.base + KOFF + (size_t)(32 * tix + row) * 64 + ((cs ^ ((row >> 1) & 7)) * 8), (unsigned)__builtin_amdgcn_readfirstlane((int)(ldsb + PC_K + sl * 4096 + p * 1024))); }
#pragma unroll
    for (int p = 0; p < 4; ++p) { const int row = 8 * p + rl;
        glds16(u.base + (size_t)(32 * (u.qb0 + F.wave) + row) * 64 + ((cs ^ ((row >> 1) & 7)) * 8), (unsigned)__builtin_amdgcn_readfirstlane((int)(ldsb + PC_Q + F.wave * 4096 + p * 1024))); }
}
__device__ __forceinline__ void pc_dma_v(Frame& F, const PcUnit& u, unsigned ldsb) {
    constexpr size_t KOFF = (size_t)MP * 768;
#pragma unroll
    for (int i = 0; i < 6; ++i) { const int idx = F.wave * 6 + i, sl = idx >> 2, pc = idx & 3; int tix = u.qb0 - 4 + sl; tix = tix < 0 ? 0 : tix;
        glds16(u.base + 2 * KOFF + (size_t)(32 * tix + (pc & 1) * 16 + (F.lane >> 2)) * 64 + (pc >> 1) * 32 + (F.lane & 3) * 8, (unsigned)__builtin_amdgcn_readfirstlane((int)(ldsb + PC_V + sl * 4096 + pc * 1024))); }
}
__device__ __forceinline__ void pc_store_o(Frame& F, const PcUnit& u, const f32x16 (&ot)[2], float inv, float lse) {
    const int lane = F.lane, r32 = lane & 31, hi = lane >> 5;
    LAS unsigned char* qs = F.lds + PC_Q + F.wave * 4096;
#pragma unroll
    for (int d0 = 0; d0 < 2; ++d0)
#pragma unroll
        for (int i = 0; i < 4; ++i) { typedef unsigned u32x2w __attribute__((ext_vector_type(2)));
            u32x2w w; w.x = cvtpk(ot[d0][4 * i] * inv, ot[d0][4 * i + 1] * inv); w.y = cvtpk(ot[d0][4 * i + 2] * inv, ot[d0][4 * i + 3] * inv);
            *(LAS u32x2w*)(qs + r32 * 128 + (((4 * d0 + i) ^ ((r32 >> 1) & 7)) * 16) + hi * 8) = w; }
    const int qb = u.qb0 + F.wave;
#pragma unroll
    for (int j = 0; j < 4; ++j) { const int row = 8 * j + (lane >> 3), c = (lane & 7) ^ ((row >> 1) & 7);
        const v4u v = *(const LAS v4u*)(qs + j * 1024 + lane * 16);
        const size_t tok = u.row0 + ((size_t)(32 * qb + row) << u.sh);
        *(v4u*)(F.OG + ((size_t)u.g * MT + tok) * 256 + u.h * 64 + c * 8) = v; }
    if (hi == 0) F.LSE[((size_t)u.g * MT + u.row0 + ((size_t)(32 * qb + r32) << u.sh)) * 4 + u.h] = lse;
}
__device__ __forceinline__ void p2_sample(Frame& F, const float* const* caches) {
    for (int rep_ = 0; rep_ < NREP(9); ++rep_) {
        for (int wi = F.vcu; wi < 2 * 128; wi += F.G)
            for (int g = 0; g < 3; ++g) samp_unit(F, caches, ((((wi >> 1) * 3 + g) * 8 + F.wave) << 1) | (wi & 1));
    }
}
__device__ __forceinline__ void p2a_phase(Frame& F, const float* const* caches) {
    LAS float* tbw = (LAS float*)(F.lds + PC_TB);
    for (int i = F.tid; i < 12 * TB_N; i += NWAVES * 64) { const int gh = i / TB_N, j = i % TB_N - 32; tbw[i] = (j >= 0 && j <= 128) ? F.BIAST[gh * 132 + j] : -INFINITY; }
    __syncthreads();
#if PROBE_T >= 10 && PROBE_T <= 12
    volatile LAS unsigned long long* stp = (volatile LAS unsigned long long*)(F.lds + MISC_OFF + 640);
#define P2STAMP(k) do { __syncthreads(); if (blockIdx.x == PROBE_BLK && F.tid == 0) stp[k] = __builtin_amdgcn_s_memrealtime(); __syncthreads(); } while (0)
#else
#define P2STAMP(k) do {} while (0)
#endif
    P2STAMP(10);
    P2STAMP(11);
    const int lane = F.lane, r32 = lane & 31, hi = lane >> 5;
    const unsigned ldsb = (unsigned)(size_t)F.lds;
    const int nun = 3 * MP * 4 / 32 / NWAVES * NREP(10);
    const int kq_off = r32 * 128, kq_sw = (r32 >> 1) & 7;
    const int ltr = ((lane >> 4) & 1) * 32 + (lane & 3) * 8 + (4 * hi + ((lane & 15) >> 2)) * 64;
    const int upw = (nun + F.G - 1) / F.G;
    int grp = F.vcu * upw; const int gend = grp + upw < nun ? grp + upw : nun;
    const bool sfirst = (((int)blockIdx.x >> 3) & 1) != 0;
    if (sfirst) p2_sample(F, caches);
    if (grp >= gend) { if (!sfirst) p2_sample(F, caches); return; }
    const int per_g = upw / 3 > 0 ? upw / 3 : 1; const bool mix = (upw % 3 == 0) && (F.G * upw == 3072);
#define PC_SLOT2UNIT(sl) ({ const int s_ = (sl) % 3072, w_ = s_ / upw, i_ = s_ % upw, g_ = i_ / per_g < 3 ? i_ / per_g : 2, n_ = (w_ * per_g + (i_ - g_ * per_g)) & 1023; \
        mix ? (((n_ >> 7) * 3 + g_) * 4 + ((n_ >> 5) & 3)) * 32 + (n_ & 31) : s_; })
    PcUnit cur = pc_decode(F, PC_SLOT2UNIT(grp)), prev = cur;
    pc_dma_k(F, cur, ldsb);
    PC_WAIT_BAR();
    f32x16 ot[2]; float inv_p = 0.f, lse_p = 0.f; bool have_prev = false;
    for (;;) {
        bf16x8 qf[4];
        { const LAS unsigned char* qs = F.lds + PC_Q + F.wave * 4096 + kq_off;
#pragma unroll
          for (int d0 = 0; d0 < 4; ++d0) qf[d0] = *(const LAS bf16x8*)(qs + (((2 * d0 + hi) ^ kq_sw) << 4)); }
        asm volatile("s_waitcnt lgkmcnt(0)" ::: "memory");
        pc_dma_v(F, cur, ldsb);
        if (have_prev) pc_store_o(F, prev, ot, inv_p, lse_p);
        const int qb = cur.qb0 + F.wave;
        const LAS float* tbg = (const LAS float*)(F.lds + PC_TB) + (cur.g * 4 + cur.h) * TB_N + (r32 - 4 * hi);
        f32x16 s[5];
#pragma unroll
        for (int kt = 0; kt < 5; ++kt) {
            const LAS unsigned char* ks = F.lds + PC_K + (F.wave + kt) * 4096 + kq_off;
            bf16x8 kf[4];
#pragma unroll
            for (int d0 = 0; d0 < 4; ++d0) kf[d0] = *(const LAS bf16x8*)(ks + (((2 * d0 + hi) ^ kq_sw) << 4));
            const LAS float* tb = tbg + ((qb - 4 + kt < 0) ? 223 : 160 - 32 * kt);
            f32x16 c;
#pragma unroll
            for (int i = 0; i < 16; ++i) c[i] = tb[-(i & 3) - 8 * (i >> 2)];
#pragma unroll
            for (int d0 = 0; d0 < 4; ++d0) c = __builtin_amdgcn_mfma_f32_32x32x16_bf16(kf[d0], qf[d0], c, 0, 0, 0);
            s[kt] = c;
        }
        float mx = -INFINITY;
#pragma unroll
        for (int kt = 0; kt < 5; ++kt)
#pragma unroll
            for (int i = 0; i < 16; ++i) mx = fmaxf(mx, s[kt][i]);
        mx = fmaxf(mx, __shfl_xor(mx, 32));
        float ls = 0.f;
#pragma unroll
        for (int kt = 0; kt < 5; ++kt)
#pragma unroll
            for (int i = 0; i < 16; ++i) { const float p = __builtin_amdgcn_exp2f(s[kt][i] - mx); s[kt][i] = p; ls += p; }
        ls += __shfl_xor(ls, 32);
        PC_WAIT_BAR();
        const int ngrp = grp + 1; const bool has_next = ngrp < gend;
        PcUnit nxt = cur;
        if (has_next) { nxt = pc_decode(F, PC_SLOT2UNIT(ngrp)); pc_dma_k(F, nxt, ldsb); }
#pragma unroll
        for (int i = 0; i < 16; ++i) { ot[0][i] = 0.f; ot[1][i] = 0.f; }
#pragma unroll
        for (int kt = 0; kt < 5; ++kt) {
            const LAS unsigned char* vb = F.lds + PC_V + (F.wave + kt) * 4096;
#pragma unroll
            for (int ks = 0; ks < 2; ++ks) {
                v4u pw; pw.x = cvtpk(s[kt][8 * ks + 0], s[kt][8 * ks + 1]); pw.y = cvtpk(s[kt][8 * ks + 2], s[kt][8 * ks + 3]); pw.z = cvtpk(s[kt][8 * ks + 4], s[kt][8 * ks + 5]); pw.w = cvtpk(s[kt][8 * ks + 6], s[kt][8 * ks + 7]);
                const bf16x8 pf = __builtin_bit_cast(bf16x8, pw);
#pragma unroll
                for (int d0 = 0; d0 < 2; ++d0) {
                    const s16x4 lo = vtr(vb + (d0 * 2 + ks) * 1024 + ltr), hh = vtr(vb + (d0 * 2 + ks) * 1024 + ltr + 512);
                    const bf16x8 vf = (bf16x8){lo[0], lo[1], lo[2], lo[3], hh[0], hh[1], hh[2], hh[3]};
                    ot[d0] = __builtin_amdgcn_mfma_f32_32x32x16_bf16(vf, pf, ot[d0], 0, 0, 0);
                }
            }
        }
        inv_p = 1.f / ls; lse_p = mx + __builtin_amdgcn_logf(ls); prev = cur; have_prev = true;
        PC_WAIT_BAR();
        if (!has_next) break;
        cur = nxt; grp = ngrp;
    }
    pc_store_o(F, prev, ot, inv_p, lse_p);
    asm volatile("s_waitcnt lgkmcnt(0)" ::: "memory");
    P2STAMP(12);
    if (!sfirst) p2_sample(F, caches);
}
__device__ __forceinline__ void p2b_token(Frame& F, int R) {
    const int l = F.lane, h = l >> 4;
    const bool samp = R >= MP;
    const int b = samp ? (R - MP) >> 3 : R >> 13, t = samp ? (R - MP) & 7 : R & 8191;
    if (!samp) {
        const float l0 = F.LSE[((size_t)0 * MT + R) * 4 + h], l1 = F.LSE[((size_t)1 * MT + R) * 4 + h], l2 = F.LSE[((size_t)2 * MT + R) * 4 + h];
        const float mm = fmaxf(l0, fmaxf(l1, l2));
        float w0 = __builtin_amdgcn_exp2f(l0 - mm), w1 = __builtin_amdgcn_exp2f(l1 - mm), w2 = __builtin_amdgcn_exp2f(l2 - mm);
        const float wi = 1.f / (w0 + w1 + w2); w0 *= wi; w1 *= wi; w2 *= wi;
        float a0, a1, a2, a3, b0, b1, b2, b3, c0, c1, c2, c3;
        ld_bf4(F.OG + ((size_t)0 * MT + R) * 256 + 4 * l, a0, a1, a2, a3); ld_bf4(F.OG + ((size_t)1 * MT + R) * 256 + 4 * l, b0, b1, b2, b3); ld_bf4(F.OG + ((size_t)2 * MT + R) * 256 + 4 * l, c0, c1, c2, c3);
        *(uint2*)(F.AB + (size_t)R * 768 + 4 * l) = make_uint2(pk2(w0 * a0 + w1 * b0 + w2 * c0, w0 * a1 + w1 * b1 + w2 * c1), pk2(w0 * a2 + w1 * b2 + w2 * c2, w0 * a3 + w1 * b3 + w2 * c3));
    } else {
        const int rs = R - MP; float lv[6], mm = -INFINITY;
#pragma unroll
        for (int p = 0; p < 6; ++p) { lv[p] = F.SLSE[((size_t)p * MS + rs) * 4 + h]; mm = fmaxf(mm, lv[p]); }
        float ws = 0.f, o0 = 0.f, o1 = 0.f, o2 = 0.f, o3 = 0.f;
#pragma unroll
        for (int p = 0; p < 6; ++p) { const float w = __builtin_amdgcn_exp2f(lv[p] - mm); float a0, a1, a2, a3; ld_bf4(F.SOG + ((size_t)p * MS + rs) * 256 + 4 * l, a0, a1, a2, a3);
            ws += w; o0 += w * a0; o1 += w * a1; o2 += w * a2; o3 += w * a3; }
        const float wi = 1.f / ws;
        *(uint2*)(F.AB + (size_t)R * 768 + 4 * l) = make_uint2(pk2(o0 * wi, o1 * wi), pk2(o2 * wi, o3 * wi));
    }
    const int c = 8 * l;
    const bf16* pr = F.CBU + (size_t)R * 1024 + c;
    float cb[8], u0[8], u1[8], u2[8];
    ld_bf8(pr, cb); ld_bf8(pr + 512, u0);
    if (t >= 1) ld_bf8(pr - 1024 + 512, u1);
    else if (samp) { const f32x4 a = *(const f32x4*)(F.sconv + (size_t)(b * 2 + 1) * 512 + c), d = *(const f32x4*)(F.sconv + (size_t)(b * 2 + 1) * 512 + c + 4);
        u1[0] = a.x; u1[1] = a.y; u1[2] = a.z; u1[3] = a.w; u1[4] = d.x; u1[5] = d.y; u1[6] = d.z; u1[7] = d.w; }
    else {
#pragma unroll
        for (int i = 0; i < 8; ++i) u1[i] = 0.f; }
    if (t >= 2) ld_bf8(pr - 2048 + 512, u2);
    else if (samp) { const f32x4 a = *(const f32x4*)(F.sconv + (size_t)(b * 2 + t) * 512 + c), d = *(const f32x4*)(F.sconv + (size_t)(b * 2 + t) * 512 + c + 4);
        u2[0] = a.x; u2[1] = a.y; u2[2] = a.z; u2[3] = a.w; u2[4] = d.x; u2[5] = d.y; u2[6] = d.z; u2[7] = d.w; }
    else {
#pragma unroll
        for (int i = 0; i < 8; ++i) u2[i] = 0.f; }
    float z[8];
#pragma unroll
    for (int i = 0; i < 8; ++i) z[i] = cb[i] * (F.conv_b[c + i] + F.conv_w[c + i] * u2[i] + F.conv_w[512 + c + i] * u1[i] + F.conv_w[1024 + c + i] * u0[i]);
    v4u w; w.x = pk2(z[0], z[1]); w.y = pk2(z[2], z[3]); w.z = pk2(z[4], z[5]); w.w = pk2(z[6], z[7]);
    *(v4u*)(F.AB + (size_t)R * 768 + 256 + c) = w;
}
__device__ __forceinline__ void p2b_quad(Frame& F, int R0) {
    const int l = F.lane, h = l >> 4, c = 8 * l;
    float ls[4][3]; uint2 og[4][3]; v4u cbw[4], uw[6];
#pragma unroll
    for (int i = 0; i < 4; ++i)
#pragma unroll
        for (int g = 0; g < 3; ++g) { ls[i][g] = F.LSE[((size_t)g * MT + R0 + i) * 4 + h]; og[i][g] = *(const uint2*)(F.OG + ((size_t)g * MT + R0 + i) * 256 + 4 * l); }
#pragma unroll
    for (int i = 0; i < 4; ++i) cbw[i] = *(const v4u*)(F.CBU + (size_t)(R0 + i) * 1024 + c);
#pragma unroll
    for (int i = 0; i < 6; ++i) uw[i] = *(const v4u*)(F.CBU + (size_t)(R0 - 2 + i) * 1024 + 512 + c);
    float cw0[8], cw1[8], cw2[8], cbi[8];
#pragma unroll
    for (int j = 0; j < 8; ++j) { cbi[j] = F.conv_b[c + j]; cw0[j] = F.conv_w[c + j]; cw1[j] = F.conv_w[512 + c + j]; cw2[j] = F.conv_w[1024 + c + j]; }
#pragma unroll
    for (int i = 0; i < 4; ++i) {
        const float mm = fmaxf(ls[i][0], fmaxf(ls[i][1], ls[i][2]));
        float w0 = __builtin_amdgcn_exp2f(ls[i][0] - mm), w1 = __builtin_amdgcn_exp2f(ls[i][1] - mm), w2 = __builtin_amdgcn_exp2f(ls[i][2] - mm);
        const float wi = 1.f / (w0 + w1 + w2); w0 *= wi; w1 *= wi; w2 *= wi;
#define BLO(x) __uint_as_float((x) << 16)
#define BHI(x) __uint_as_float((x) & 0xffff0000u)
        const float m0 = w0 * BLO(og[i][0].x) + w1 * BLO(og[i][1].x) + w2 * BLO(og[i][2].x), m1 = w0 * BHI(og[i][0].x) + w1 * BHI(og[i][1].x) + w2 * BHI(og[i][2].x);
        const float m2 = w0 * BLO(og[i][0].y) + w1 * BLO(og[i][1].y) + w2 * BLO(og[i][2].y), m3 = w0 * BHI(og[i][0].y) + w1 * BHI(og[i][1].y) + w2 * BHI(og[i][2].y);
        *(uint2*)(F.AB + (size_t)(R0 + i) * 768 + 4 * l) = make_uint2(pk2(m0, m1), pk2(m2, m3));
        float z[8];
#pragma unroll
        for (int j = 0; j < 4; ++j) {
            const unsigned cbx = cbw[i][j], a2 = uw[i][j], a1 = uw[i + 1][j], a0 = uw[i + 2][j];
            z[2 * j]     = BLO(cbx) * (cbi[2 * j] + cw0[2 * j] * BLO(a2) + cw1[2 * j] * BLO(a1) + cw2[2 * j] * BLO(a0));
            z[2 * j + 1] = BHI(cbx) * (cbi[2 * j + 1] + cw0[2 * j + 1] * BHI(a2) + cw1[2 * j + 1] * BHI(a1) + cw2[2 * j + 1] * BHI(a0));
        }
#undef BLO
#undef BHI
        v4u w; w.x = pk2(z[0], z[1]); w.y = pk2(z[2], z[3]); w.z = pk2(z[4], z[5]); w.w = pk2(z[6], z[7]);
        *(v4u*)(F.AB + (size_t)(R0 + i) * 768 + 256 + c) = w;
    }
}
template <int NR> __device__ __forceinline__ void p8_rows(Frame& F, int m0, int mstride) {
    typedef unsigned u32x2v __attribute__((ext_vector_type(2)));
    u32x2v w[NR][4];
#pragma unroll
    for (int r = 0; r < NR; ++r) { const GAS u32x2v* xr = (const GAS u32x2v*)(F.MB + (size_t)(m0 + r * mstride) * DM) + F.lane;
#pragma unroll
        for (int j = 0; j < 4; ++j) w[r][j] = xr[64 * j]; }
    f32x4 g[4];
#pragma unroll
    for (int j = 0; j < 4; ++j) g[j] = *((const f32x4*)F.g_fin + F.lane + 64 * j);
#pragma unroll
    for (int r = 0; r < NR; ++r) { f32x4 v[4]; float s = 0.f;
#pragma unroll
        for (int j = 0; j < 4; ++j) { v[j] = (f32x4){__uint_as_float(w[r][j].x << 16), __uint_as_float(w[r][j].x & 0xffff0000u), __uint_as_float(w[r][j].y << 16), __uint_as_float(w[r][j].y & 0xffff0000u)};
            s += (v[j].x * v[j].x + v[j].y * v[j].y) + (v[j].z * v[j].z + v[j].w * v[j].w); }
        const float rs = 1.0f / sqrtf(wave_sum(s) * (1.f / DM) + EPS);
        GAS f32x4* o = (GAS f32x4*)(F.out + (size_t)(m0 + r * mstride) * DM) + F.lane;
#pragma unroll
        for (int j = 0; j < 4; ++j) o[64 * j] = v[j] * rs * g[j]; }
}

typedef float f32x4v __attribute__((ext_vector_type(4)));
constexpr int SM_ROWSUM_OFF = MISC_OFF + 256;
template <int KW> __device__ __forceinline__ void sm_partial(const bf16* A, int lda, const bf16* Bt, int ldb, int r0, int c0, int k0, int wave, int lane, f32x4v (&acc)[4][4]) {
    const bf16* ap = A + (size_t)(r0 + (lane & 15)) * lda + k0 + wave * KW + 8 * (lane >> 4);
    const bf16* bp = Bt + (size_t)(c0 + (lane & 15)) * ldb + k0 + wave * KW + 8 * (lane >> 4);
#pragma unroll 2
    for (int k = 0; k < KW; k += 32) {
        bf16x8 af[4], bfr[4];
#pragma unroll
        for (int i = 0; i < 4; ++i) { af[i] = *(const bf16x8*)(ap + (size_t)(16 * i) * lda + k); bfr[i] = *(const bf16x8*)(bp + (size_t)(16 * i) * ldb + k); }
#pragma unroll
        for (int i = 0; i < 4; ++i)
#pragma unroll
            for (int j = 0; j < 4; ++j) acc[i][j] = __builtin_amdgcn_mfma_f32_16x16x32_bf16(bfr[j], af[i], acc[i][j], 0, 0, 0);
    }
}
__device__ __forceinline__ void sm_reduce(Frame& F, const f32x4v (&acc)[4][4], f32x4v (&out)[2]) {
    LAS f32x4v* red = (LAS f32x4v*)(F.lds + RING_OFF);
#pragma unroll
    for (int i = 0; i < 4; ++i)
#pragma unroll
        for (int j = 0; j < 4; ++j) red[(F.wave * 16 + i * 4 + j) * 64 + F.lane] = acc[i][j];
    __syncthreads();
#pragma unroll
    for (int q = 0; q < 2; ++q) { f32x4v t = red[F.tid + 512 * q];
#pragma unroll
        for (int w = 1; w < 8; ++w) t += red[w * 1024 + F.tid + 512 * q];
        out[q] = t; }
    __syncthreads();
}
#define SM_ZERO(acc) do { _Pragma("unroll") for (int i_ = 0; i_ < 4; ++i_) _Pragma("unroll") for (int j_ = 0; j_ < 4; ++j_) acc[i_][j_] = (f32x4v){0.f, 0.f, 0.f, 0.f}; } while (0)
#define SM_SLOT(q, row, col) const int s_ = F.tid + 512 * (q), f_ = s_ >> 6, l_ = s_ & 63; const int row = r0 + 16 * (f_ >> 2) + (l_ & 15), col = c0 + 16 * (f_ & 3) + 4 * (l_ >> 4)
__device__ __forceinline__ float sigm(float x) { return __builtin_amdgcn_rcpf(1.f + __builtin_amdgcn_exp2f(-LOG2E * x)); }
__device__ __forceinline__ void sm_gate(Frame& F, int u) {
    const int r0 = (u >> 4) * 64, c0 = (u & 15) * 64;
    const bf16* A = F.AB + (size_t)MP * 768;
    f32x4v acc[4][4], oa[2], ob[2];
    SM_ZERO(acc); sm_partial<32>(A, 768, F.WAC_T, 768, r0, c0, 0, F.wave, F.lane, acc); sm_reduce(F, acc, oa);
    SM_ZERO(acc); sm_partial<64>(A, 768, F.WAC_T, 768, r0, c0, 256, F.wave, F.lane, acc); sm_reduce(F, acc, ob);
#pragma unroll
    for (int q = 0; q < 2; ++q) { SM_SLOT(q, row, col);
        float a0, a1, a2, a3, b0, b1, b2, b3; const int rit = row & 255, cit = col & 255;
        const bf16* gp = F.GT + (size_t)((256 + (row >> 8)) * 4 + (col >> 8)) * 2 * 65536 + (size_t)((((((rit >> 6) & 1) * 4 + (cit >> 6)) * 2 + (rit >> 7)) * 4 + ((rit >> 4) & 3)) * 2 + ((cit >> 5) & 1)) * 512 + (((cit >> 3) & 3) * 16 + (rit & 15)) * 8 + (cit & 7); ld_bf4(gp, a0, a1, a2, a3); ld_bf4(gp + 65536, b0, b1, b2, b3);
        const float m0 = b0 * (a0 * oa[q][0] + ob[q][0]), m1 = b1 * (a1 * oa[q][1] + ob[q][1]), m2 = b2 * (a2 * oa[q][2] + ob[q][2]), m3 = b3 * (a3 * oa[q][3] + ob[q][3]);
        *(uint2*)(F.MB + (size_t)(MP + row) * DM + col) = make_uint2(pk2(m0, m1), pk2(m2, m3)); }
}
__device__ __forceinline__ void sm_oproj(Frame& F, int u) {
    const int r0 = (u >> 4) * 64, c0 = (u & 15) * 64;
    LAS float* rsum = (LAS float*)(F.lds + SM_ROWSUM_OFF);
    if (F.tid < 64) rsum[F.tid] = 0.f;
    f32x4v acc[4][4], o[2];
    SM_ZERO(acc); sm_partial<128>(F.MB + (size_t)MP * DM, DM, F.WO_T, DM, r0, c0, 0, F.wave, F.lane, acc); sm_reduce(F, acc, o);
#pragma unroll
    for (int q = 0; q < 2; ++q) { SM_SLOT(q, row, col);
        bf16* xp = F.XB + (size_t)(MP + row) * DM + col; float x0, x1, x2, x3; ld_bf4(xp, x0, x1, x2, x3); const float xn = F.RSTD0[MP + row];
        const float v0 = x0 * xn + o[q][0], v1 = x1 * xn + o[q][1], v2 = x2 * xn + o[q][2], v3 = x3 * xn + o[q][3];
        *(uint2*)xp = make_uint2(pk2(v0, v1), pk2(v2, v3));
        __hip_atomic_fetch_add(rsum + (row - r0), (v0 * v0 + v1 * v1) + (v2 * v2 + v3 * v3), __ATOMIC_RELAXED, __HIP_MEMORY_SCOPE_WORKGROUP); }
    __syncthreads();
    if (F.tid < 64) F.SSQ1[(size_t)(MP + r0 + F.tid) * 16 + (u & 15)] = rsum[F.tid];
    __syncthreads();
}
__device__ __forceinline__ void sm_down(Frame& F, int u) {
    const int r0 = (u >> 4) * 64, c0 = (u & 15) * 64;
    f32x4v acc[4][4], o[2];
    SM_ZERO(acc);
    {
        const int lane = F.lane, rit = (r0 & 255) + (lane & 15);
        const bf16* ap = F.HID + ((size_t)(256 + (r0 >> 8)) * 64 + F.wave * 8) * 16384 + (size_t)rit * 64 + 8 * (lane >> 4);
        const bf16* bp = F.W2_T + (size_t)(c0 + (lane & 15)) * FF + F.wave * 512 + 8 * (lane >> 4);
#pragma unroll 2
        for (int k = 0; k < 512; k += 32) {
            bf16x8 af[4], bfr[4];
#pragma unroll
            for (int i = 0; i < 4; ++i) { af[i] = *(const bf16x8*)(ap + (size_t)(k >> 6) * 16384 + (size_t)(16 * i) * 64 + (k & 32)); bfr[i] = *(const bf16x8*)(bp + (size_t)(16 * i) * FF + k); }
#pragma unroll
            for (int i = 0; i < 4; ++i)
#pragma unroll
                for (int j = 0; j < 4; ++j) acc[i][j] = __builtin_amdgcn_mfma_f32_16x16x32_bf16(bfr[j], af[i], acc[i][j], 0, 0, 0);
        }
    }
    sm_reduce(F, acc, o);
#pragma unroll
    for (int q = 0; q < 2; ++q) { SM_SLOT(q, row, col);
        float x0, x1, x2, x3; ld_bf4(F.XB + (size_t)(MP + row) * DM + col, x0, x1, x2, x3);
        const f32x4* sp = (const f32x4*)(F.SSQ1 + (size_t)(MP + row) * 16); const f32x4 t0 = sp[0], t1 = sp[1], t2 = sp[2], t3 = sp[3];
        const float rs2 = __builtin_amdgcn_rcpf((((t0[0] + t0[1]) + (t0[2] + t0[3])) + ((t1[0] + t1[1]) + (t1[2] + t1[3])) + ((t2[0] + t2[1]) + (t2[2] + t2[3])) + ((t3[0] + t3[1]) + (t3[2] + t3[3]))) * (1.f / DM) + EPS);
        *(uint2*)(F.MB + (size_t)(MP + row) * DM + col) = make_uint2(pk2(x0 + rs2 * o[q][0], x1 + rs2 * o[q][1]), pk2(x2 + rs2 * o[q][2], x3 + rs2 * o[q][3])); }
}

struct Args { const float* in[18]; float* out; unsigned char* ws; int ph_lo, ph_hi, li, pad; };
__global__ void __launch_bounds__(NWAVES * 64, 2) mk_fwd(Args args) {
    extern __shared__ __attribute__((aligned(16))) unsigned char lds[];
    Frame F;
    F.lds = (LAS unsigned char*)lds;
    F.MISC = (volatile LAS unsigned*)(F.lds + MISC_OFF);
    F.tid = threadIdx.x; F.lane = F.tid & 63; F.wave = __builtin_amdgcn_readfirstlane(F.tid >> 6);
    F.G = gridDim.x; { const int bx = blockIdx.x; F.vcu = (F.G % 8 == 0) ? (bx % 8) * (F.G / 8) + bx / 8 : bx; }
    unsigned char* ws = args.ws;
    F.ctl = (gu32*)(ws + WS_CTL);
    F.xp = args.in[0]; F.xs = args.in[1];  F.sconv = args.in[5];
    F.w_in = args.in[6]; F.w_ao = args.in[7]; F.w_co = args.in[8]; F.w_o = args.in[9]; F.conv_w = args.in[10]; F.conv_b = args.in[11]; F.rel_bias = args.in[12];
    F.g_mix = args.in[13]; F.g_mlp = args.in[14]; F.w_ff1 = args.in[15]; F.w_ff2 = args.in[16]; F.g_fin = args.in[17];
    F.out = args.out;
    F.WIN_T = (bf16*)(ws + WS_WIN); F.WAC_T = (bf16*)(ws + WS_WAC); F.WO_T = (bf16*)(ws + WS_WO); F.W1_T = (bf16*)(ws + WS_W1); F.W2_T = (bf16*)(ws + WS_W2);
    F.XB = (bf16*)(ws + WS_XB); F.HID = (bf16*)(ws + WS_HID); F.AB = (bf16*)(ws + WS_AB); F.MB = (bf16*)(ws + WS_MB); F.OG = (bf16*)(ws + WS_MB); F.QKV = (bf16*)(ws + WS_QKV);
    F.SQ = (bf16*)(ws + WS_SQ); F.SOG = (bf16*)(ws + WS_SOG); F.SLSE = (float*)(ws + WS_SOG + (size_t)6 * MS * 256 * 2); F.CBU = (bf16*)(ws + WS_CBU); F.GT = (bf16*)(ws + WS_GT);
    F.RSTD0 = (float*)(ws + WS_RSTD0); F.SSQ1 = (float*)(ws + WS_SSQ1); F.BIAST = (float*)(ws + WS_BIAST); F.LSE = (float*)(ws + WS_LSE);
    for (int u = F.tid; u < (LDS_BYTES - LDSCTL_OFF) / 4; u += NWAVES * 64) ((LAS unsigned*)(F.lds + LDSCTL_OFF))[u] = 0u;
    __syncthreads();
    XcdBarrier bar; bar.bar = (unsigned*)(F.ctl + CW_BAR); bar.x = 0; bar.st = nullptr;
    if (N_LAUNCHES != PER_PHASE) bar = xcd_barrier_post((unsigned*)(F.ctl + CW_BAR), F.MISC + 8);
#define GRID_BAR() do { if (N_LAUNCHES != PER_PHASE) xcd_barrier(bar); } while (0)
#if PROBE_T >= 0
    volatile LAS unsigned long long* stamps = (volatile LAS unsigned long long*)(F.lds + MISC_OFF + 640);
#define STAMP(k) do { if (blockIdx.x == PROBE_BLK && F.tid == 0) { stamps[k] = __builtin_amdgcn_s_memrealtime(); stamps[16 + (k)] = __builtin_amdgcn_s_memtime(); } } while (0)
#else
#define STAMP(k) do {} while (0)
#endif
    STAMP(0);
    const int lo = args.ph_lo, hi = args.ph_hi;
#define IN(k) (lo <= (k) && (k) < hi)
#define BOTH(k) (IN(k) && IN((k) + 1))
    const int gw = F.vcu * NWAVES + F.wave, NGW = F.G * NWAVES;

    if (IN(0)) { for (int rep_ = 0; rep_ < NREP(0); ++rep_) p0_prologue(F); if (BOTH(0)) GRID_BAR(); STAMP(1); }
    if (IN(1)) {
        pg8::Gemm g{F.XB, F.WIN_T, MT, PW, DM}; pg8::StaticOrder S; S.init(MT, PW, F.G, (int)blockIdx.x, NREP(1));
        pg8::EpiProj E{F.out, F.QKV, F.SQ, F.CBU, F.GT, F.lds + EPI_STAGE_OFF};
        pg8::gemm_phase<pg8::EpiProj, pg8::StaticOrder, true, true>(F.lds + RING_OFF, g, S, E);
        {
            const int ntile = (MT / 256) * (PW / 256), nfull = ntile % F.G;
            if (nfull == 0) p1_tail_weights(F, (int)blockIdx.x * NWAVES + F.wave, F.G * NWAVES);
            else if ((int)blockIdx.x >= nfull) p1_tail_weights(F, ((int)blockIdx.x - nfull) * NWAVES + F.wave, (F.G - nfull) * NWAVES);
        }
        if (BOTH(1)) GRID_BAR(); STAMP(2);
    }
    if (IN(2)) { for (int rep_ = 0; rep_ < NREP(2); ++rep_) p2a_phase(F, &args.in[2]); if (BOTH(2)) GRID_BAR(); STAMP(3); }
    if (IN(3)) { for (int rep_ = 0; rep_ < NREP(3); ++rep_) {
            for (int R0 = 4 * gw; R0 < MP; R0 += 4 * NGW) { if ((R0 & 8191) != 0) p2b_quad(F, R0); else { p2b_token(F, R0); p2b_token(F, R0 + 1); p2b_token(F, R0 + 2); p2b_token(F, R0 + 3); } }
            for (int sidx = gw; sidx < 2 * MS; sidx += NGW) if (!(sidx & 1)) p2b_token(F, MP + (sidx >> 1));
        } if (BOTH(3)) GRID_BAR(); STAMP(4); }
    const bool early = (((int)blockIdx.x >> 3) & 1) != 0;
    if (IN(4)) {
        if (early) for (int u = F.vcu; u < 256; u += F.G) sm_gate(F, u);
        pg8::Gemm g{F.AB, F.WAC_T, MP, DM, 768}; pg8::StaticOrder S; S.init(MP, DM, F.G, (int)blockIdx.x, NREP(4));
        pg8::EpiGate E{F.MB, F.GT, F.lds + EPI_STAGE_OFF};
        pg8::gemm_phase<pg8::EpiGate, pg8::StaticOrder, true, true>(F.lds + RING_OFF, g, S, E);
        if (!early) for (int u = F.vcu; u < 256; u += F.G) sm_gate(F, u);
        if (BOTH(4)) GRID_BAR(); STAMP(5);
    }
    if (IN(5)) {
        if (early) for (int u = F.vcu; u < 256; u += F.G) sm_oproj(F, u);
        pg8::Gemm g{F.MB, F.WO_T, MP, DM, DM}; pg8::StaticOrder S; S.init(MP, DM, F.G, (int)blockIdx.x, NREP(5));
        pg8::EpiRes1 E{F.XB, F.SSQ1, F.RSTD0, F.lds + EPI_STAGE_OFF};
        pg8::gemm_phase<pg8::EpiRes1, pg8::StaticOrder, true, true>(F.lds + RING_OFF, g, S, E);
        if (!early) for (int u = F.vcu; u < 256; u += F.G) sm_oproj(F, u);
        if (BOTH(5)) GRID_BAR(); STAMP(6);
    }
    if (IN(6)) {
        pg8::Gemm g{F.XB, F.W1_T, MT, FF, DM}; pg8::StaticOrder S; S.init(MT, FF, F.G, (int)blockIdx.x, NREP(6));
        pg8::EpiFF1 E{F.HID, F.SSQ1, F.lds + EPI_STAGE_OFF};
        pg8::gemm_phase<pg8::EpiFF1, pg8::StaticOrder, true, true>(F.lds + RING_OFF, g, S, E);
        if (BOTH(6)) GRID_BAR(); STAMP(7);
    }
    if (IN(7)) {
        if (early) for (int u = F.vcu; u < 256; u += F.G) sm_down(F, u);
        pg8::Gemm g{F.HID, F.W2_T, MP, DM, FF}; pg8::StaticOrder S; S.init(MP, DM, F.G, (int)blockIdx.x, NREP(7));
        pg8::EpiRes2 E{F.XB, F.MB, F.SSQ1, F.lds + EPI_STAGE_OFF};
        pg8::gemm_phase<pg8::EpiRes2, pg8::StaticOrder, true, true, true>(F.lds + RING_OFF, g, S, E);
        if (!early) for (int u = F.vcu; u < 256; u += F.G) sm_down(F, u);
        if (BOTH(7)) GRID_BAR(); STAMP(8);
    }
#if (PROBE_DUP >> 17) & 31
    {
        GRID_BAR();
        pg8::Gemm g{F.XB, F.WO_T, MP, DM, DM};
        pg8::StaticOrder S; S.init(MP, DM, F.G, (int)blockIdx.x, 4);
#if (PROBE_DUP >> 17) & 1
        pg8::EpiNone E{}; pg8::gemm_phase<pg8::EpiNone, pg8::StaticOrder, true, true>(F.lds + RING_OFF, g, S, E);
#elif (PROBE_DUP >> 18) & 1
#if (PROBE_DUP >> 21) & 1
        { const unsigned long long t0 = __builtin_amdgcn_s_memrealtime(), d = (unsigned long long)((F.vcu & 31) * 80); while (__builtin_amdgcn_s_memrealtime() - t0 < d) __builtin_amdgcn_s_sleep(4); }
#endif
        pg8::EpiNone E{}; pg8::gemm_phase<pg8::EpiNone, pg8::StaticOrder, true, true>(F.lds + RING_OFF, g, S, E);
#elif (PROBE_DUP >> 19) & 1
        pg8::EpiNone E{}; pg8::gemm_phase<pg8::EpiNone, pg8::StaticOrder, true, true>(F.lds + RING_OFF, g, S, E);
#else
        pg8::EpiNone E{}; pg8::gemm_phase<pg8::EpiNone, pg8::StaticOrder, true, true>(F.lds + RING_OFF, g, S, E);
#endif
        GRID_BAR();
    }
#endif
#if ((PROBE_DUP >> 11) & 63) || ((PROBE_DUP >> 22) & 1)
    {
        GRID_BAR();
        pg8::Gemm g{F.XB, F.W1_T, MT, FF, DM}; if ((PROBE_DUP >> 11) & 1) { g.pm_mask = 1; g.pn_mask = 3; }
        pg8::StaticOrder S; S.init(MT, FF, F.G, (int)blockIdx.x);
#if (PROBE_DUP >> 13) & 1
        pg8::EpiNone E{};
        pg8::gemm_phase<pg8::EpiNone, pg8::StaticOrder, true, true>(F.lds + RING_OFF, g, S, E);
#elif (PROBE_DUP >> 14) & 1
        pg8::EpiNone E{};
        pg8::gemm_phase<pg8::EpiNone, pg8::StaticOrder, true, true>(F.lds + RING_OFF, g, S, E);
#elif (PROBE_DUP >> 22) & 1
        pg8::EpiNone E{};
        pg8::gemm_phase<pg8::EpiNone, pg8::StaticOrder, true, true>(F.lds + RING_OFF, g, S, E);
#elif (PROBE_DUP >> 16) & 1
        pg8::EpiNone E{};
        pg8::gemm_phase<pg8::EpiNone, pg8::StaticOrder, true, true>(F.lds + RING_OFF, g, S, E);
#elif (PROBE_DUP >> 15) & 1
        pg8::EpiNone E{};
        pg8::gemm_phase<pg8::EpiNone, pg8::StaticOrder, true, true>(F.lds + RING_OFF, g, S, E);
#else
        pg8::EpiFF1 E{F.HID, F.SSQ1, F.lds + EPI_STAGE_OFF};
        pg8::gemm_phase<pg8::EpiFF1, pg8::StaticOrder, true, true>(F.lds + RING_OFF, g, S, E);
#endif
        GRID_BAR();
    }
#endif
    if (IN(8)) { int m = gw; for (; m + 3 * NGW < MT; m += 4 * NGW) p8_rows<4>(F, m, NGW); for (; m < MT; m += NGW) p8_rows<1>(F, m, NGW); }
#if PROBE_T >= 0
    {
        STAMP(9);
        if (blockIdx.x == PROBE_BLK && F.tid == 0) {
            const int k = PROBE_T % 100;
            const unsigned long long dr = (PROBE_T == 12 ? stamps[3] : stamps[k + 1]) - stamps[k], dc = stamps[16 + k + 1] - stamps[16 + k];
            const unsigned long long spin = PROBE_T >= 100 ? (dc * 100ull / dr) * 20ull : dr * PROBE_MULT;
            const unsigned long long t0 = __builtin_amdgcn_s_memrealtime();
            while (__builtin_amdgcn_s_memrealtime() - t0 < spin) __builtin_amdgcn_s_sleep(16);
        }
    }
#endif
#undef IN
#undef BOTH
}

extern "C" void kernel_launch(void* const* d_in, const int* in_sizes, int n_in, void* d_out, int out_size, void* d_ws, size_t ws_size, hipStream_t stream) {
    static int grid = 0;
    if (grid == 0) {
        if (n_in != 18 || in_sizes[0] != MP * DM || (size_t)out_size != pg8::O_END || ws_size < WS_END) { fprintf(stderr, "kernel_launch: unexpected shapes: n_in %d in0 %d out %d ws %zu (need %zu)\n", n_in, n_in > 0 ? in_sizes[0] : -1, out_size, ws_size, (size_t)WS_END); grid = -1; return; }
        int dev = 0, cus = 0, per_cu = 0;
        if (hipGetDevice(&dev) != hipSuccess || hipDeviceGetAttribute(&cus, hipDeviceAttributeMultiprocessorCount, dev) != hipSuccess) { fprintf(stderr, "kernel_launch: device query failed\n"); grid = -1; return; }
        if (hipFuncSetAttribute((const void*)mk_fwd, hipFuncAttributeMaxDynamicSharedMemorySize, LDS_BYTES) != hipSuccess) { fprintf(stderr, "kernel_launch: hipFuncSetAttribute failed\n"); grid = -1; return; }
        if (hipOccupancyMaxActiveBlocksPerMultiprocessor(&per_cu, (const void*)mk_fwd, NWAVES * 64, LDS_BYTES) != hipSuccess || per_cu < 1) { fprintf(stderr, "kernel_launch: occupancy query reports %d blocks per CU\n", per_cu); }
        (void)hipGetLastError();
        grid = cus;
    }
    if (grid < 0) return;
    if (hipMemsetAsync((char*)d_ws + WS_CTL, 0, CTL_ZERO_BYTES, stream) != hipSuccess) { fprintf(stderr, "kernel_launch: memset failed\n"); return; }
    Args a{};
    for (int i = 0; i < 18; ++i) a.in[i] = (const float*)d_in[i];
    a.out = (float*)d_out; a.ws = (unsigned char*)d_ws;
    for (int li = 0; li < N_LAUNCHES; ++li) {
        a.ph_lo = (N_LAUNCHES == PER_PHASE) ? li : 0; a.ph_hi = (N_LAUNCHES == PER_PHASE) ? li + 1 : PER_PHASE; a.li = li;
        hipLaunchKernelGGL(mk_fwd, dim3(grid), dim3(NWAVES * 64), LDS_BYTES, stream, a);
        const hipError_t le = hipPeekAtLastError();
        if (le != hipSuccess) { fprintf(stderr, "kernel_launch: launch %d failed: %s\n", li, hipGetErrorName(le)); break; }
    }
}
```
